# Optimizing an MI355X kernel written in HIP

```python
import math
import jax, jax.numpy as jnp
from jax import lax
import numpy as np

D_MODEL = 2048
BATCH = 2
SEQ = 8192
DEPTH = 1

N_META = 16
CONV_W = D_MODEL // 2
N_CONV_GROUPS = 16
CONV_K = 3
RWKV_W = D_MODEL // 2
HEAD_N = 64
N_RWKV_HEADS = RWKV_W // HEAD_N
DECAY_LORA = 96
AAA_LORA = 96
GATE_LORA = 256
D_FF = 5632
FFN_K = 3
RMS_EPS = 1e-6
GN_EPS = 64e-5
DECAY_SCALE = math.exp(-0.5)

CONV_COLS = 3 * CONV_W
RWKV_COLS = 3 * RWKV_W + DECAY_LORA + AAA_LORA + GATE_LORA
IN_COLS = CONV_COLS + RWKV_COLS

kernel_name = "hymba_conv_rwkv7_hybrid_layer"


def rmsnorm(x, g):
    xf = x.astype(jnp.float32)
    y = xf * lax.rsqrt(jnp.mean(xf * xf, axis=-1, keepdims=True) + RMS_EPS)
    return (y * g.astype(jnp.float32)).astype(x.dtype)


def causal_dwconv(x, w):
    k = w.shape[0]
    seq_len = x.shape[1]
    xp = jnp.pad(x, ((0, 0), (k - 1, 0), (0, 0)))
    y = xp[:, 0:seq_len] * w[0]
    for i in range(1, k):
        y = y + xp[:, i:i + seq_len] * w[i]
    return y


def token_shift(z, mu):
    z_prev = jnp.pad(z, ((0, 0), (1, 0), (0, 0)))[:, :-1]
    return z + (z_prev - z) * mu


def rwkv7_scan(r, w, k, v, a_vec, b_vec):
    bsz, _, h, n = r.shape
    xs = tuple(jnp.swapaxes(t, 0, 1) for t in (r, w, k, v, a_vec, b_vec))

    def step(s, inp):
        r_t, w_t, k_t, v_t, a_t, b_t = inp
        sa = jnp.einsum('bhvk,bhk->bhv', s, a_t)
        s = s * w_t[:, :, None, :] + sa[..., None] * b_t[:, :, None, :] + v_t[..., None] * k_t[:, :, None, :]
        y_t = jnp.einsum('bhvk,bhk->bhv', s, r_t)
        return s, y_t

    s0 = jnp.zeros((bsz, h, n, n), jnp.float32)
    _, ys = lax.scan(step, s0, xs)
    return jnp.swapaxes(ys, 0, 1)


def short_conv_group(zc, conv_w):
    gate_b, gate_c, hx = jnp.split(zc, 3, axis=-1)
    return gate_b * causal_dwconv(gate_c * hx, conv_w)


def rwkv7_group(zr, mu_rwkv, w_decay_up, w0, a_up, a0, g_up, k_k, k_a, r_k, ln_x_w, ln_x_b):
    bsz, seq_len, _ = zr.shape
    zr = token_shift(zr, mu_rwkv)
    o1 = RWKV_W; o2 = 2 * RWKV_W; o3 = 3 * RWKV_W
    o4 = o3 + DECAY_LORA; o5 = o4 + AAA_LORA
    r = zr[..., :o1]
    k = zr[..., o1:o2]
    v = zr[..., o2:o3]
    wd = zr[..., o3:o4]
    ad = zr[..., o4:o5]
    gd = zr[..., o5:]

    f32 = jnp.float32
    log_w = -DECAY_SCALE * jax.nn.sigmoid((w0 + jnp.tanh(wd) @ w_decay_up).astype(f32))
    a = jax.nn.sigmoid(a0 + ad @ a_up)
    g = jax.nn.sigmoid(gd) @ g_up

    hs = (bsz, seq_len, N_RWKV_HEADS, HEAD_N)
    kk = (k * k_k).astype(f32).reshape(hs)
    kk = kk / jnp.maximum(jnp.sqrt(jnp.sum(kk * kk, axis=-1, keepdims=True)), 1e-12)
    k = k * (1.0 + (a - 1.0) * k_a)

    r_h = r.astype(f32).reshape(hs)
    k_h = k.astype(f32).reshape(hs)
    v_h = v.astype(f32).reshape(hs)
    a_h = a.astype(f32).reshape(hs)
    y = rwkv7_scan(r_h, jnp.exp(log_w).reshape(hs), k_h, v_h, -kk, kk * a_h)

    mean = jnp.mean(y, axis=-1, keepdims=True)
    var = jnp.mean(jnp.square(y - mean), axis=-1, keepdims=True)
    y = (y - mean) * lax.rsqrt(var + GN_EPS)
    y = y.reshape(bsz, seq_len, RWKV_W) * ln_x_w.astype(f32) + ln_x_b.astype(f32)
    bonus = jnp.sum(r_h * k_h * r_k.astype(f32), axis=-1, keepdims=True) * v_h
    y = y + bonus.reshape(bsz, seq_len, RWKV_W)
    return (y * g.astype(f32)).astype(zr.dtype)


def conv_glu(x, w_gate_up, conv_ffn, w_down):
    gu = x @ w_gate_up
    gate, up = jnp.split(gu, 2, axis=-1)
    gate = causal_dwconv(gate, conv_ffn)
    return (jax.nn.silu(gate) * up) @ w_down


def setup_inputs(seed: int = 0) -> dict:
    key = jax.random.key(seed)
    ks = jax.random.split(key, 24)
    f32 = jnp.float32
    nrm = lambda k, shape, s: jax.random.normal(k, shape, f32) * s
    d = D_MODEL
    return {
        "x": nrm(ks[0], (BATCH, SEQ, d), 1.0),
        "meta_tokens": nrm(ks[1], (N_META, d), 1.0),
        "g_pre_mix": 1.0 + nrm(ks[2], (d,), 0.05),
        "w_in": nrm(ks[3], (d, IN_COLS), d ** -0.5),
        "conv_w": nrm(ks[4], (CONV_K, CONV_W), CONV_K ** -0.5),
        "mu_rwkv": jax.random.uniform(ks[5], (RWKV_COLS,), f32, 0.1, 0.9),
        "w_decay_up": nrm(ks[6], (DECAY_LORA, RWKV_W), 0.1 * DECAY_LORA ** -0.5),
        "w0": nrm(ks[7], (RWKV_W,), 0.5) - 0.5,
        "a_up": nrm(ks[8], (AAA_LORA, RWKV_W), 0.1 * AAA_LORA ** -0.5),
        "a0": nrm(ks[9], (RWKV_W,), 0.1),
        "g_up": nrm(ks[10], (GATE_LORA, RWKV_W), GATE_LORA ** -0.5),
        "k_k": 0.85 + nrm(ks[11], (RWKV_W,), 0.05),
        "k_a": 1.0 + nrm(ks[12], (RWKV_W,), 0.05),
        "r_k": nrm(ks[13], (N_RWKV_HEADS, HEAD_N), 0.1),
        "ln_x_w": 1.0 + nrm(ks[14], (RWKV_W,), 0.05),
        "ln_x_b": nrm(ks[15], (RWKV_W,), 0.02),
        "w_out": nrm(ks[16], (CONV_W + RWKV_W, d), (CONV_W + RWKV_W) ** -0.5),
        "g_post_mix": 1.0 + nrm(ks[17], (d,), 0.05),
        "g_pre_ffn": 1.0 + nrm(ks[18], (d,), 0.05),
        "w_gate_up": nrm(ks[19], (d, 2 * D_FF), d ** -0.5),
        "conv_ffn": nrm(ks[20], (FFN_K, D_FF), FFN_K ** -0.5),
        "w_down": nrm(ks[21], (D_FF, d), D_FF ** -0.5),
        "g_post_ffn": 1.0 + nrm(ks[22], (d,), 0.05),
    }


def reference(x, meta_tokens, g_pre_mix, w_in, conv_w, mu_rwkv, w_decay_up, w0, a_up, a0,
              g_up, k_k, k_a, r_k, ln_x_w, ln_x_b, w_out, g_post_mix, g_pre_ffn,
              w_gate_up, conv_ffn, w_down, g_post_ffn):
    bsz = x.shape[0]
    meta = jnp.broadcast_to(meta_tokens.astype(x.dtype)[None], (bsz, N_META, x.shape[-1]))
    h = jnp.concatenate([meta, x], axis=1)

    for _ in range(DEPTH):
        n = rmsnorm(h, g_pre_mix)
        z = n @ w_in
        y_conv = short_conv_group(z[..., :CONV_COLS], conv_w)
        y_rwkv = rwkv7_group(z[..., CONV_COLS:], mu_rwkv, w_decay_up, w0, a_up, a0, g_up,
                             k_k, k_a, r_k, ln_x_w, ln_x_b)
        mix = jnp.concatenate([y_conv, y_rwkv], axis=-1) @ w_out
        h = h + rmsnorm(mix, g_post_mix)
        f = conv_glu(rmsnorm(h, g_pre_ffn), w_gate_up, conv_ffn, w_down)
        h = h + rmsnorm(f, g_post_ffn)

    return h[:, N_META:]
```

```cpp
#include <hip/hip_runtime.h>
#include <hip/hip_cooperative_groups.h>
#include <cstdio>
#include <cstdint>
namespace cg = cooperative_groups;
namespace pg8 {
#define PG8_LAS __attribute__((address_space(3)))
typedef unsigned short bf16_t;
typedef short bf16x8 __attribute__((ext_vector_type(8)));
typedef float f32x4 __attribute__((ext_vector_type(4)));
typedef unsigned u32x4 __attribute__((ext_vector_type(4)));
constexpr int BM = 256, BK = 64, HALF = 128, HTB = HALF * BK * 2  , STAGE_BYTES = 8 * HTB, NXCD = 8, WGM = 8;

__host__ __device__ __forceinline__ int lds_byte(int r, int c) { const int st = (r >> 4) * 2 + (c >> 5), rr = r & 15, cc = c & 31, ob = rr * 64 + cc * 2; return st * 1024 + (ob ^ (((ob >> 9) & 1) << 5)); }
__host__ __device__ __forceinline__ void stage_rc(int b, int& R, int& C) { const int st = b / 1024, sb = b % 1024, swz = sb ^ (((sb >> 9) & 1) << 5); R = (st >> 1) * 16 + swz / 64; C = (st & 1) * 32 + (swz % 64) / 2; }
__host__ __device__ __forceinline__ int perm32(int rho) { const int n = rho >> 4, i = rho & 15; return 8 * (i >> 2) + 4 * n + (i & 3); }

struct Unit { int pm, pn; };
struct Gemm { const bf16_t* A; const bf16_t* Bt; int M, N, K; };

struct StaticOrder {
    int nM, nN, nwg, G, c;
    __host__ __device__ void init(int M, int N, int G_, int c_) { nM = M / BM; nN = N / BM; nwg = nM * nN; G = G_; c = c_; }
    __host__ __device__ bool next(int i, Unit& u) const {
        const long L = (long)i * G + c; if (L >= nwg) return false;
        int wgid = (int)L; { const int q = nwg / NXCD, r = nwg % NXCD, xcd = wgid % NXCD, off = wgid / NXCD; wgid = (xcd < r ? xcd * (q + 1) : r * (q + 1) + (xcd - r) * q) + off; }
        const int nig = WGM * nN, gid = wgid / nig, fm = gid * WGM, gsz = (nM - fm) < WGM ? (nM - fm) : WGM;
        u.pm = fm + ((wgid % nig) % gsz); u.pn = (wgid % nig) / gsz; return true;
    }
    __device__ __forceinline__ void a_ready(const Unit&) const {}
    __device__ __forceinline__ void done(const Unit&) const {}
};
__device__ __forceinline__ unsigned cvt_pk_bf16(float lo, float hi) { unsigned r; asm volatile("v_cvt_pk_bf16_f32 %0, %1, %2" : "=v"(r) : "v"(lo), "v"(hi)); return r; }
template <class Epi, class Sched, bool ALIGN_EPI = false, bool SP2 = false>
__device__ __forceinline__ void gemm_phase(PG8_LAS unsigned char* lds, const Gemm g, const Sched& S, const Epi& E) {
    const int tid = threadIdx.x, wid = __builtin_amdgcn_readfirstlane(tid >> 6), lane = tid & 63, wr = wid >> 2, wc = wid & 3, fr = lane & 15, fq = lane >> 4;
    const int K = g.K, nt = K / BK;
    unsigned voffA[2], voffB[2];
#pragma unroll
    for (int i = 0; i < 2; ++i) { int R, C; stage_rc(tid * 16 + i * 8192, R, C); const int Rb = Epi::PERM ? ((R & ~31) + perm32(R & 31)) : R;
        voffA[i] = (unsigned)(R * K + C) * 2u; voffB[i] = (unsigned)(Rb * K + C) * 2u; }
    const size_t kstep = (size_t)(BK * 2);
    const size_t hstep = (size_t)HALF * K * 2;
    const size_t tstep = 2 * hstep;
    const unsigned ldsw = (unsigned)wid * 1024u;
    const int aoff = lds_byte(wr * 64 + fr, fq * 8), boff = lds_byte(wc * 32 + fr, fq * 8);
#define PG8_SA(b, h) (((b) * 2 + (h)) * HTB)
#define PG8_SB(b, h) ((4 + (b) * 2 + (h)) * HTB)
#define PG8_STAGE(bufoff, gbase, voff) do { _Pragma("unroll") for (int _i = 0; _i < 2; ++_i) \
        __builtin_amdgcn_global_load_lds((const unsigned*)((const char*)(gbase) + (voff)[_i]), (PG8_LAS unsigned*)(lds + (bufoff) + ldsw + _i * 8192), 16, 0, 0); } while (0)
#define PG8_LDA(dst, b, h) do { _Pragma("unroll") for (int m = 0; m < 4; ++m) _Pragma("unroll") for (int k = 0; k < 2; ++k) dst[m][k] = *(const PG8_LAS bf16x8*)(lds + PG8_SA(b, h) + aoff + m * 2048 + k * 1024); } while (0)
#define PG8_LDB(dst, b, h) do { _Pragma("unroll") for (int n = 0; n < 2; ++n) _Pragma("unroll") for (int k = 0; k < 2; ++k) dst[n][k] = *(const PG8_LAS bf16x8*)(lds + PG8_SB(b, h) + boff + n * 2048 + k * 1024); } while (0)
#define PG8_MMA(ai, bj, At, Bt) do { __builtin_amdgcn_s_setprio(1); _Pragma("unroll") for (int m = 0; m < 4; ++m) _Pragma("unroll") for (int n = 0; n < 2; ++n) _Pragma("unroll") for (int k = 0; k < 2; ++k) \
        acc[ai][bj][m][n] = __builtin_amdgcn_mfma_f32_16x16x32_bf16(Bt[n][k], At[m][k], acc[ai][bj][m][n], 0, 0, 0); __builtin_amdgcn_s_setprio(0); } while (0)
#define PG8_WAIT_V(n) asm volatile("s_waitcnt vmcnt(" #n ")" ::: "memory")
#define PG8_WAIT_L(n) asm volatile("s_waitcnt lgkmcnt(" #n ")" ::: "memory")
#define PG8_BAR __builtin_amdgcn_s_barrier()
#define PG8_SCHED __builtin_amdgcn_sched_barrier(0)
    Unit cur, nxt; int ui = 0;
    if (!S.next(0, cur)) return;
    f32x4 acc[2][2][4][2];
#pragma unroll
    for (int a = 0; a < 2; ++a)
#pragma unroll
        for (int b = 0; b < 2; ++b)
#pragma unroll
            for (int m = 0; m < 4; ++m)
#pragma unroll
                for (int n = 0; n < 2; ++n) acc[a][b][m][n] = (f32x4){0.f, 0.f, 0.f, 0.f};
    bf16x8 At[4][2], B0[2][2], B1[2][2];
    const char* cA = (const char*)g.A + (size_t)cur.pm * tstep; const char* cB = (const char*)g.Bt + (size_t)cur.pn * tstep;
    S.a_ready(cur);
    if constexpr (SP2) {
        PG8_STAGE(PG8_SB(0, 0), cB, voffB); PG8_STAGE(PG8_SB(0, 1), cB + hstep, voffB); PG8_STAGE(PG8_SA(0, 0), cA, voffA); PG8_STAGE(PG8_SA(0, 1), cA + hstep, voffA);
        if (wr == 1) PG8_BAR;
        PG8_WAIT_V(2); PG8_BAR;
        PG8_STAGE(PG8_SB(1, 0), cB + kstep, voffB); PG8_STAGE(PG8_SA(1, 0), cA + kstep, voffA); PG8_STAGE(PG8_SB(1, 1), cB + hstep + kstep, voffB);
        PG8_WAIT_V(6); PG8_BAR;
    } else {
        PG8_STAGE(PG8_SB(0, 0), cB, voffB); PG8_STAGE(PG8_SA(0, 0), cA, voffA); PG8_STAGE(PG8_SB(0, 1), cB + hstep, voffB); PG8_STAGE(PG8_SA(0, 1), cA + hstep, voffA);
        if (wr == 1) PG8_BAR;
        PG8_WAIT_V(4); PG8_BAR;
        PG8_STAGE(PG8_SB(1, 0), cB + kstep, voffB); PG8_STAGE(PG8_SA(1, 0), cA + kstep, voffA); PG8_STAGE(PG8_SB(1, 1), cB + hstep + kstep, voffB);
        PG8_WAIT_V(6); PG8_BAR;
    }
    for (;;) {
        const bool has_next = S.next(ui + 1, nxt);
        const char* nA = has_next ? (const char*)g.A + (size_t)nxt.pm * tstep : cA; const char* nB = has_next ? (const char*)g.Bt + (size_t)nxt.pn * tstep : cB;
        for (int t = 0; t < nt; t += 2) {
            const bool last = (t == nt - 2);
            const char* a1 = cA + (size_t)(t + 1) * kstep;
            const char* a2 = last ? nA : cA + (size_t)(t + 2) * kstep; const char* b2 = last ? nB : cB + (size_t)(t + 2) * kstep;
            const char* a3 = a2 + kstep; const char* b3 = b2 + kstep;
            if (last && has_next) S.a_ready(nxt);
            if constexpr (SP2) {
            PG8_LDB(B0, 0, 0); PG8_LDB(B1, 0, 1); PG8_SCHED; PG8_LDA(At, 0, 0); PG8_STAGE(PG8_SA(1, 1), a1 + hstep, voffA);
            PG8_WAIT_V(8); PG8_WAIT_L(0); PG8_BAR; PG8_MMA(0, 0, At, B0); PG8_MMA(0, 1, At, B1); PG8_BAR; PG8_SCHED;
            PG8_LDA(At, 0, 1); PG8_STAGE(PG8_SB(0, 0), b2, voffB); PG8_STAGE(PG8_SB(0, 1), b2 + hstep, voffB); PG8_STAGE(PG8_SA(0, 0), a2, voffA);
            PG8_WAIT_V(8); PG8_WAIT_L(0); PG8_BAR; PG8_MMA(1, 0, At, B0); PG8_MMA(1, 1, At, B1); PG8_BAR; PG8_SCHED;
            PG8_LDB(B0, 1, 0); PG8_LDB(B1, 1, 1); PG8_SCHED; PG8_LDA(At, 1, 0); PG8_STAGE(PG8_SA(0, 1), a2 + hstep, voffA);
            PG8_WAIT_V(8); PG8_WAIT_L(0); PG8_BAR; PG8_MMA(0, 0, At, B0); PG8_MMA(0, 1, At, B1); PG8_BAR; PG8_SCHED;
            PG8_LDA(At, 1, 1); PG8_STAGE(PG8_SB(1, 0), b3, voffB); PG8_STAGE(PG8_SB(1, 1), b3 + hstep, voffB); PG8_STAGE(PG8_SA(1, 0), a3, voffA);
            PG8_WAIT_V(8); PG8_WAIT_L(0); PG8_BAR; PG8_MMA(1, 0, At, B0); PG8_MMA(1, 1, At, B1); PG8_BAR; PG8_SCHED;
            } else {
            PG8_LDB(B0, 0, 0); PG8_SCHED; PG8_LDA(At, 0, 0); PG8_STAGE(PG8_SA(1, 1), a1 + hstep, voffA);
            PG8_WAIT_L(8); PG8_BAR; PG8_WAIT_L(0); PG8_MMA(0, 0, At, B0); PG8_BAR; PG8_SCHED;
            PG8_LDB(B1, 0, 1); PG8_STAGE(PG8_SB(0, 0), b2, voffB);
            PG8_BAR; PG8_WAIT_L(0); PG8_MMA(0, 1, At, B1); PG8_BAR;
            PG8_LDA(At, 0, 1); PG8_STAGE(PG8_SA(0, 0), a2, voffA);
            PG8_BAR; PG8_WAIT_L(0); PG8_MMA(1, 0, At, B0); PG8_BAR; PG8_SCHED;
            PG8_STAGE(PG8_SB(0, 1), b2 + hstep, voffB);
            PG8_WAIT_V(6); PG8_BAR; PG8_MMA(1, 1, At, B1); PG8_BAR;
            PG8_LDB(B0, 1, 0); PG8_SCHED; PG8_LDA(At, 1, 0); PG8_STAGE(PG8_SA(0, 1), a2 + hstep, voffA);
            PG8_WAIT_L(8); PG8_BAR; PG8_WAIT_L(0); PG8_MMA(0, 0, At, B0); PG8_BAR; PG8_SCHED;
            PG8_LDB(B1, 1, 1); PG8_STAGE(PG8_SB(1, 0), b3, voffB);
            PG8_BAR; PG8_WAIT_L(0); PG8_MMA(0, 1, At, B1); PG8_BAR;
            PG8_LDA(At, 1, 1); PG8_STAGE(PG8_SA(1, 0), a3, voffA);
            PG8_BAR; PG8_WAIT_L(0); PG8_MMA(1, 0, At, B0); PG8_BAR; PG8_SCHED;
            PG8_STAGE(PG8_SB(1, 1), b3 + hstep, voffB);
            PG8_WAIT_V(6); PG8_BAR; PG8_MMA(1, 1, At, B1); PG8_BAR;
            }
        }
        if constexpr (ALIGN_EPI) { if (wr == 0) PG8_BAR; }
        if constexpr (!Epi::AFTER_DRAIN) { E(acc, cur, wr, wc, fr, fq); S.done(cur); }
        if (!has_next) break;
#pragma unroll
        for (int a = 0; a < 2; ++a)
#pragma unroll
            for (int b = 0; b < 2; ++b)
#pragma unroll
                for (int m = 0; m < 4; ++m)
#pragma unroll
                    for (int n = 0; n < 2; ++n) acc[a][b][m][n] = (f32x4){0.f, 0.f, 0.f, 0.f};
        cur = nxt; cA = nA; cB = nB; ++ui;
        if constexpr (ALIGN_EPI) { if (wr == 1) PG8_BAR; }
    }
    PG8_WAIT_V(0);
    if constexpr (!ALIGN_EPI) { if (wr == 0) PG8_BAR; }
    PG8_BAR;
    if constexpr (Epi::AFTER_DRAIN) { E.fused(acc, cur, wr, wc, fr, fq, lds, wid, lane); S.done(cur); }
#undef PG8_SA
#undef PG8_SB
#undef PG8_STAGE
#undef PG8_LDA
#undef PG8_LDB
#undef PG8_MMA
#undef PG8_WAIT_V
#undef PG8_WAIT_L
#undef PG8_BAR
#undef PG8_SCHED
}
struct EpiSplit2 {
    static constexpr bool PERM = true, AFTER_DRAIN = false;
    bf16_t* O0; int ld0; bf16_t* O1; int ld1; int split_col;
    __device__ __forceinline__ void operator()(const f32x4 (&acc)[2][2][4][2], const Unit& u, int wr, int wc, int fr, int fq) const {
        const int row0 = u.pm * BM + wr * 64 + fr; int colt = u.pn * BM; bf16_t* base = O0; int ldc = ld0;
        if (colt >= split_col) { base = O1; ldc = ld1; colt -= split_col; }
        const int col0 = colt + wc * 32 + 8 * fq;
#pragma unroll
        for (int ai = 0; ai < 2; ++ai)
#pragma unroll
            for (int m = 0; m < 4; ++m) { bf16_t* rowp = base + (size_t)(row0 + ai * HALF + m * 16) * ldc + col0;
#pragma unroll
                for (int bj = 0; bj < 2; ++bj) { const f32x4 v0 = acc[ai][bj][m][0], v1 = acc[ai][bj][m][1];
                    u32x4 w; w.x = cvt_pk_bf16(v0[0], v0[1]); w.y = cvt_pk_bf16(v0[2], v0[3]); w.z = cvt_pk_bf16(v1[0], v1[1]); w.w = cvt_pk_bf16(v1[2], v1[3]);
                    *(u32x4*)(rowp + bj * HALF) = w; } }
    }
};
struct EpiF32 {
    static constexpr bool PERM = false, AFTER_DRAIN = false;
    float* C; int ldc;
    __device__ __forceinline__ void operator()(const f32x4 (&acc)[2][2][4][2], const Unit& u, int wr, int wc, int fr, int fq) const {
        const int row0 = u.pm * BM + wr * 64 + fr, col0 = u.pn * BM + wc * 32 + 4 * fq;
#pragma unroll
        for (int ai = 0; ai < 2; ++ai)
#pragma unroll
            for (int m = 0; m < 4; ++m) { float* rowp = C + (size_t)(row0 + ai * HALF + m * 16) * ldc + col0;
#pragma unroll
                for (int bj = 0; bj < 2; ++bj)
#pragma unroll
                    for (int n = 0; n < 2; ++n) *(f32x4*)(rowp + bj * HALF + n * 16) = acc[ai][bj][m][n]; }
    }
};
struct EpiAct {
    static constexpr bool PERM = true, AFTER_DRAIN = false;
    bf16_t* ACT; float* G4; float* U2; const float* cw; int dff;
    __device__ __forceinline__ void operator()(const f32x4 (&acc)[2][2][4][2], const Unit& u, int wr, int wc, int fr, int fq) const {
        const int lane = (int)(threadIdx.x & 63);
        const int colg = u.pn * HALF + wc * 32 + 8 * fq;
        const int src1 = (lane & 48) | ((fr + 15) & 15), src2 = (lane & 48) | ((fr + 14) & 15);
        f32x4 w0[2], w1[2], w2[2];
#pragma unroll
        for (int n = 0; n < 2; ++n) { w0[n] = *(const f32x4*)(cw + colg + 4 * n); w1[n] = *(const f32x4*)(cw + dff + colg + 4 * n); w2[n] = *(const f32x4*)(cw + 2 * dff + colg + 4 * n); }
#pragma unroll
        for (int ai = 0; ai < 2; ++ai) {
            const int rowb = u.pm * BM + ai * HALF + wr * 64;
            const int rb = rowb >> 6;
            f32x4 c1[2], c2[2];
#pragma unroll
            for (int n = 0; n < 2; ++n) { c1[n] = (f32x4){0.f, 0.f, 0.f, 0.f}; c2[n] = c1[n]; }
#pragma unroll
            for (int m = 0; m < 4; ++m) {
                u32x4 wout; unsigned pk[4];
#pragma unroll
                for (int n = 0; n < 2; ++n) {
                    const f32x4 g = acc[ai][0][m][n], up = acc[ai][1][m][n];
                    f32x4 s1, s2, o;
#pragma unroll
                    for (int x = 0; x < 4; ++x) { s1[x] = __shfl(g[x], src1); s2[x] = __shfl(g[x], src2); }
#pragma unroll
                    for (int x = 0; x < 4; ++x) {
                        const float p1 = fr >= 1 ? s1[x] : c1[n][x], p2 = fr >= 2 ? s2[x] : c2[n][x];
                        const float cv = w0[n][x] * p2 + w1[n][x] * p1 + w2[n][x] * g[x];
                        o[x] = cv / (1.0f + __expf(-cv)) * up[x];
                    }
                    c1[n] = s1; c2[n] = s2;
                    pk[2 * n] = cvt_pk_bf16(o[0], o[1]); pk[2 * n + 1] = cvt_pk_bf16(o[2], o[3]);
                    if (m == 0 && fr < 2) { *(f32x4*)(G4 + (size_t)(rb * 4 + fr) * dff + colg + 4 * n) = g; *(f32x4*)(U2 + (size_t)(rb * 2 + fr) * dff + colg + 4 * n) = up; }
                    if (m == 3 && fr >= 14) { *(f32x4*)(G4 + (size_t)(rb * 4 + 2 + (fr - 14)) * dff + colg + 4 * n) = g; }
                }
                wout.x = pk[0]; wout.y = pk[1]; wout.z = pk[2]; wout.w = pk[3];
                *(u32x4*)(ACT + (size_t)(rowb + m * 16 + fr) * dff + colg) = wout;
            }
        }
    }
};
}
constexpr int DM = 2048, NBATCH = 2, SEQ = 8192, NMETA = 16;
constexpr int MX = NBATCH * SEQ;
constexpr int MROWS = MX + NMETA;
constexpr int MP = 16640;
constexpr int LSEQ = SEQ + NMETA;
constexpr int NCH = 129;
constexpr int NHEAD = 16;
constexpr int IN_COLS = 6592, IN_PAD = 6656, ZC_LD = 3072, ZR_LD = 3584;
constexpr int DFF = 5632;
constexpr int NITEM = NBATCH * NCH * NHEAD;
constexpr float RMS_EPS = 1e-6f, GN_EPS = 64e-5f, DECAY_SCALE = 0.60653065971263342f;
constexpr int NWAVES = 8, NTHR = 512;
constexpr int LDS_BYTES = 147456;
constexpr size_t MiB = 1u << 20;
constexpr size_t WS_WIN = 1 * MiB, WS_WOUT = 27 * MiB, WS_WLORA = 35 * MiB, WS_BUFA = 38 * MiB;
constexpr size_t WS_ZR = 103 * MiB, WS_LODA = 217 * MiB, WS_LOG = 282 * MiB, WS_ZC = 315 * MiB, WS_LA = 413 * MiB;
constexpr size_t WS_MF = 315 * MiB, C1ARR = (size_t)NITEM * 8192, WS_QF = WS_MF + C1ARR, WS_NB = WS_QF + C1ARR, WS_Y1 = WS_NB + C1ARR;
constexpr size_t WS_HST = 444 * MiB, WS_BON = 476 * MiB + 512 * 1024;
constexpr size_t WS_WGU = 217 * MiB, WS_WDN = 478 * MiB;
constexpr size_t WS_MIX = 262 * MiB, WS_ACT = 262 * MiB, WS_G4 = 438 * MiB, WS_U2 = 460 * MiB, WS_F = 103 * MiB;
constexpr size_t WS_MIXM = 501 * MiB, WS_N2M = 501 * MiB + 256 * 1024, WS_GM = 501 * MiB + 512 * 1024, WS_END = 502 * MiB;
static_assert(WS_Y1 + C1ARR <= WS_HST && WS_HST + C1ARR <= WS_BON && WS_BON + (size_t)NBATCH * NCH * 64 * NHEAD * 4 <= WS_WDN, "ws map");

typedef unsigned short bf16;
typedef unsigned v4u __attribute__((ext_vector_type(4)));
typedef unsigned v2u __attribute__((ext_vector_type(2)));
typedef float f32x4 __attribute__((ext_vector_type(4)));
typedef short bf16x8 __attribute__((ext_vector_type(8)));
#define LDS_WAIT() asm volatile("s_waitcnt lgkmcnt(0)" ::: "memory")
#define DI __device__ __forceinline__
DI unsigned f2bf(float f) { unsigned u = __builtin_bit_cast(unsigned, f); return (u + 0x7fffu + ((u >> 16) & 1u)) >> 16; }
DI unsigned pk2(float lo, float hi) { return f2bf(lo) | (f2bf(hi) << 16); }
DI float bflo(unsigned w) { return __builtin_bit_cast(float, w << 16); }
DI float bfhi(unsigned w) { return __builtin_bit_cast(float, w & 0xffff0000u); }
DI float bf2f(bf16 b) { return __builtin_bit_cast(float, ((unsigned)b) << 16); }
DI void unpack8(const v4u w, float (&o)[8]) { o[0] = bflo(w.x); o[1] = bfhi(w.x); o[2] = bflo(w.y); o[3] = bfhi(w.y); o[4] = bflo(w.z); o[5] = bfhi(w.z); o[6] = bflo(w.w); o[7] = bfhi(w.w); }
DI v4u pack8(const float (&o)[8]) { v4u w; w.x = pk2(o[0], o[1]); w.y = pk2(o[2], o[3]); w.z = pk2(o[4], o[5]); w.w = pk2(o[6], o[7]); return w; }
DI float sigmoidf_(float x) { return 1.0f / (1.0f + __expf(-x)); }
DI float wave_sum(float v) {
#pragma unroll
    for (int o = 1; o < 64; o <<= 1) v += __shfl_xor(v, o);
    return v;
}
DI int prev_row(int t) { if (t >= MX) return t == MX ? -1 : t - 1; return (t % SEQ == 0) ? (MX + NMETA - 1) : t - 1; }

struct Args { const float* in[23]; float* out; unsigned char* ws; };

DI void tr_item(const float* W, int N, bf16* WT, int Kd, int k0, int n0, int drow0, float* scr, int lane) {
#pragma unroll 8
    for (int i = 0; i < 32; ++i) { const int kk = 2 * i + (lane >> 5); scr[kk * 33 + (lane & 31)] = W[(size_t)(k0 + kk) * N + n0 + (lane & 31)]; }
    LDS_WAIT();
    const int c = lane & 7;
#pragma unroll
    for (int j = 0; j < 4; ++j) { const int n = (lane >> 3) + 8 * j; const float* s = scr + (8 * c) * 33 + n;
        v4u o; o.x = pk2(s[0 * 33], s[1 * 33]); o.y = pk2(s[2 * 33], s[3 * 33]); o.z = pk2(s[4 * 33], s[5 * 33]); o.w = pk2(s[6 * 33], s[7 * 33]);
        *(v4u*)(WT + (size_t)(drow0 + n) * Kd + k0 + 8 * c) = o; }
    LDS_WAIT();
}
DI void rms_row_bf16(const float* src, const float* gain, bf16* dst, int lane) {
    v2u* o8 = (v2u*)dst + lane;
    if (!src) {
#pragma unroll
        for (int j = 0; j < 8; ++j) o8[64 * j] = (v2u){0u, 0u};
        return; }
    const f32x4* xr = (const f32x4*)src + lane; const f32x4* gr = (const f32x4*)gain + lane;
    f32x4 v[8]; float s = 0.f;
#pragma unroll
    for (int j = 0; j < 8; ++j) { v[j] = xr[64 * j]; s += (v[j].x * v[j].x + v[j].y * v[j].y) + (v[j].z * v[j].z + v[j].w * v[j].w); }
    const float rs = 1.0f / sqrtf(wave_sum(s) * (1.0f / DM) + RMS_EPS);
#pragma unroll
    for (int j = 0; j < 8; ++j) { const f32x4 g = gr[64 * j]; o8[64 * j] = (v2u){pk2(v[j].x * rs * g.x, v[j].y * rs * g.y), pk2(v[j].z * rs * g.z, v[j].w * rs * g.w)}; }
}
DI void gemv2(const bf16* a0, const bf16* a1, const bf16* brow, int K, int lane, float& o0, float& o1) {
    float s0 = 0.f, s1 = 0.f;
    for (int k = lane * 8; k < K; k += 512) {
        float x0[8], x1[8], w[8]; unpack8(*(const v4u*)(a0 + k), x0); unpack8(*(const v4u*)(a1 + k), x1); unpack8(*(const v4u*)(brow + k), w);
#pragma unroll
        for (int e = 0; e < 8; ++e) { s0 += x0[e] * w[e]; s1 += x1[e] * w[e]; }
    }
    o0 = wave_sum(s0); o1 = wave_sum(s1);
}
DI void phase0(const Args& A, unsigned char* lds, int gw, int NGW, int wave, int lane) {
    unsigned char* ws = A.ws;
    float* scr = (float*)(lds + wave * 16384);
    bf16* WIN = (bf16*)(ws + WS_WIN); bf16* WOUT = (bf16*)(ws + WS_WOUT); bf16* WL = (bf16*)(ws + WS_WLORA);
    constexpr int I_IN = (DM / 64) * (IN_COLS / 32), I_OUT = (DM / 64) * (DM / 32);
    for (int it = gw; it < I_IN + I_OUT; it += NGW) {
        if (it < I_IN) { const int kb = it / (IN_COLS / 32), nb = it % (IN_COLS / 32); tr_item(A.in[3], IN_COLS, WIN, DM, kb * 64, nb * 32, nb * 32, scr, lane); }
        else { const int r = it - I_IN, kb = r / (DM / 32), nb = r % (DM / 32); tr_item(A.in[16], DM, WOUT, DM, kb * 64, nb * 32, nb * 32, scr, lane); }
    }
    for (int i = gw * 64 + lane; i < (IN_PAD - IN_COLS) * DM / 8; i += NGW * 64) ((v4u*)(WIN + (size_t)IN_COLS * DM))[i] = (v4u){0u, 0u, 0u, 0u};
    for (int i = gw * 64 + lane; i < 3072 * 512; i += NGW * 64) {
        const int n = i >> 9, k = i & 511; float v = 0.f;
        if (n < 1024) { if (k < 96) v = A.in[6][k * 1024 + n]; }
        else if (n < 2048) { if (k >= 128 && k < 224) v = A.in[8][(k - 128) * 1024 + (n - 1024)]; }
        else { if (k >= 256) v = A.in[10][(k - 256) * 1024 + (n - 2048)]; }
        WL[i] = (bf16)f2bf(v);
    }
    bf16* XN = (bf16*)(ws + WS_BUFA);
    for (int m = gw; m < MP; m += NGW) {
        const float* src = m < MX ? A.in[0] + (size_t)m * DM : (m < MROWS ? A.in[1] + (size_t)(m - MX) * DM : nullptr);
        rms_row_bf16(src, A.in[2], XN + (size_t)m * DM, lane);
    }
}
DI void convert_late(const Args& A, unsigned char* lds, int cw, int NCW, int wave, int lane) {
    unsigned char* ws = A.ws; float* scr = (float*)(lds + wave * 16384);
    bf16* WGU = (bf16*)(ws + WS_WGU); bf16* WDN = (bf16*)(ws + WS_WDN);
    constexpr int I_GU = (DM / 64) * (2 * DFF / 32), I_DN = (DFF / 64) * (DM / 32);
    for (int it = cw; it < I_GU + I_DN; it += NCW) {
        if (it < I_GU) { const int kb = it / (2 * DFF / 32), nb = it % (2 * DFF / 32); const int n0 = nb * 32; const int j = n0 < DFF ? n0 : n0 - DFF;
            const int drow = 256 * (j >> 7) + (n0 < DFF ? 0 : 128) + (j & 127);
            tr_item(A.in[19], 2 * DFF, WGU, DM, kb * 64, n0, drow, scr, lane); }
        else { const int r = it - I_GU, kb = r / (DM / 32), nb = r % (DM / 32); tr_item(A.in[21], DM, WDN, DFF, kb * 64, nb * 32, nb * 32, scr, lane); }
    }
}
DI void phase2a(const Args& A, int gw, int NGW, int lane) {
    unsigned char* ws = A.ws;
    const bf16* ZC = (const bf16*)(ws + WS_ZC); const bf16* ZR = (const bf16*)(ws + WS_ZR); bf16* YA = (bf16*)(ws + WS_BUFA); bf16* LA = (bf16*)(ws + WS_LA);
    const float* cwp = A.in[4]; const float* mu = A.in[5];
    for (int t = gw; t < MROWS; t += NGW) {
        const int t1 = prev_row(t), t2 = t1 >= 0 ? prev_row(t1) : -1;
#pragma unroll
        for (int hv = 0; hv < 2; ++hv) {
            const int c8 = lane * 16 + hv * 8;
            float bv[8], c0[8], h0[8], c1[8], h1[8], c2[8], h2[8], o[8];
            const bf16* z0 = ZC + (size_t)t * ZC_LD + c8;
            unpack8(*(const v4u*)z0, bv); unpack8(*(const v4u*)(z0 + 1024), c0); unpack8(*(const v4u*)(z0 + 2048), h0);
            if (t1 >= 0) { const bf16* z1 = ZC + (size_t)t1 * ZC_LD + c8; unpack8(*(const v4u*)(z1 + 1024), c1); unpack8(*(const v4u*)(z1 + 2048), h1); }
            else {
#pragma unroll
                for (int e = 0; e < 8; ++e) { c1[e] = 0.f; h1[e] = 0.f; } }
            if (t2 >= 0) { const bf16* z2 = ZC + (size_t)t2 * ZC_LD + c8; unpack8(*(const v4u*)(z2 + 1024), c2); unpack8(*(const v4u*)(z2 + 2048), h2); }
            else {
#pragma unroll
                for (int e = 0; e < 8; ++e) { c2[e] = 0.f; h2[e] = 0.f; } }
#pragma unroll
            for (int e = 0; e < 8; ++e) { const float w0 = cwp[c8 + e], w1 = cwp[1024 + c8 + e], w2 = cwp[2048 + c8 + e];
                o[e] = bv[e] * (w0 * (c2[e] * h2[e]) + w1 * (c1[e] * h1[e]) + w2 * (c0[e] * h0[e])); }
            *(v4u*)(YA + (size_t)t * DM + c8) = pack8(o);
        }
        int src = -1, kind = 0;
        if (lane < 12) { src = 3072 + 8 * lane; kind = 1; } else if (lane >= 16 && lane < 28) { src = 3168 + 8 * (lane - 16); kind = 2; } else if (lane >= 32) { src = 3264 + 8 * (lane - 32); kind = 3; }
        v4u outw = (v4u){0u, 0u, 0u, 0u};
        if (src >= 0) {
            float z[8], zp[8], o[8]; unpack8(*(const v4u*)(ZR + (size_t)t * ZR_LD + src), z);
            if (t1 >= 0) unpack8(*(const v4u*)(ZR + (size_t)t1 * ZR_LD + src), zp); else {
#pragma unroll
                for (int e = 0; e < 8; ++e) zp[e] = 0.f; }
#pragma unroll
            for (int e = 0; e < 8; ++e) { const float s = z[e] + (zp[e] - z[e]) * mu[src + e]; o[e] = kind == 1 ? tanhf(s) : (kind == 2 ? s : sigmoidf_(s)); }
            outw = pack8(o);
        }
        *(v4u*)(LA + (size_t)t * 512 + 8 * lane) = outw;
    }
}
constexpr int LP = 144;
constexpr int L_AT = 0, L_BT = 9216, L_KT = 18432, L_RT = 27648, L_BHT = 36864, L_KHT = 46080, L_VT = 55296, L_AAK = 64512, L_ARB = 73728, L_ARK = 82944;
constexpr int L_AAB = 92160, AABP = 68;
constexpr int L_RHS = 109568;
constexpr int L_GC = 142336;
constexpr int L_XT = L_BT;
constexpr int L_LW = L_AAB, L_SEG = L_RHS;
constexpr int L_SQ = L_AT, L_SM = L_BT, L_SN = L_KT, L_SY = L_RT;
static_assert(L_GC + 256 <= LDS_BYTES, "lds");
#define MFMA16(a, b, c) __builtin_amdgcn_mfma_f32_16x16x32_bf16((a), (b), (c), 0, 0, 0)
DI bf16x8 ldfrag(const unsigned char* base, int row, int s, int q) { return *(const bf16x8*)(base + row * LP + (s * 32 + q * 8) * 2); }
DI void st_bf(unsigned char* base, int row, int col, float v) { *(bf16*)(base + row * LP + col * 2) = (bf16)f2bf(v); }

DI void phase_c1(const Args& A, unsigned char* lds, int bx, int G, int tid, int wave, int lane) {
    unsigned char* ws = A.ws;
    const bf16* ZR = (const bf16*)(ws + WS_ZR); const bf16* LODA = (const bf16*)(ws + WS_LODA);
    float* BON = (float*)(ws + WS_BON);
    const float* mu = A.in[5]; const float* w0p = A.in[7]; const float* a0p = A.in[9]; const float* kkp = A.in[11]; const float* kap = A.in[12]; const float* rkp = A.in[13];
    const int r16 = lane & 15, q = lane >> 4;
    const int tm = wave >> 1, tn0 = (wave & 1) * 2;
    float* LW = (float*)(lds + L_LW); float* SEG = (float*)(lds + L_SEG); float* AAB = (float*)(lds + L_AAB); float* RHS = (float*)(lds + L_RHS); float* GC = (float*)(lds + L_GC);
    for (int item = bx; item < NITEM; item += G) {
        const int h = item & 15, bc = item >> 4, c = bc % NCH, b = bc / NCH;
        const int i = tid >> 3, cgp = tid & 7, c0 = cgp * 8;
        const int pos = c * 64 + i; const bool valid = pos < LSEQ;
        const int row = valid ? (pos < NMETA ? MX + pos : b * SEQ + pos - NMETA) : 0;
        const int prow = prev_row(row);
        const int col = h * 64 + c0;
        float rr[8], kr[8], vr[8], lw[8], av[8], bv[8], kp[8];
        {
            float z[8], zp[8];
            const bf16* zr = ZR + (size_t)row * ZR_LD + col; const bf16* zpr = ZR + (size_t)(prow >= 0 ? prow : 0) * ZR_LD + col;
#pragma unroll
            for (int part = 0; part < 3; ++part) {
                unpack8(*(const v4u*)(zr + part * 1024), z);
                if (prow >= 0) unpack8(*(const v4u*)(zpr + part * 1024), zp); else {
#pragma unroll
                    for (int e = 0; e < 8; ++e) zp[e] = 0.f; }
#pragma unroll
                for (int e = 0; e < 8; ++e) { const float s = z[e] + (zp[e] - z[e]) * mu[part * 1024 + col + e]; if (part == 0) rr[e] = s; else if (part == 1) kr[e] = s; else vr[e] = s; }
            }
            float dec[8], aa[8]; unpack8(*(const v4u*)(LODA + (size_t)row * 2048 + col), dec); unpack8(*(const v4u*)(LODA + (size_t)row * 2048 + 1024 + col), aa);
            float ss = 0.f, bon = 0.f, as[8], kk[8];
#pragma unroll
            for (int e = 0; e < 8; ++e) {
                lw[e] = -DECAY_SCALE * sigmoidf_(w0p[col + e] + dec[e]);
                as[e] = sigmoidf_(a0p[col + e] + aa[e]);
                kk[e] = kr[e] * kkp[col + e]; ss += kk[e] * kk[e];
                kp[e] = kr[e] * (1.0f + (as[e] - 1.0f) * kap[col + e]);
                bon += rr[e] * kp[e] * rkp[col + e];
            }
            ss += __shfl_xor(ss, 1); ss += __shfl_xor(ss, 2); ss += __shfl_xor(ss, 4);
            bon += __shfl_xor(bon, 1); bon += __shfl_xor(bon, 2); bon += __shfl_xor(bon, 4);
            const float inv = 1.0f / fmaxf(sqrtf(ss), 1e-12f);
#pragma unroll
            for (int e = 0; e < 8; ++e) { const float kn = kk[e] * inv; av[e] = -kn; bv[e] = kn * as[e]; }
            if (!valid) {
#pragma unroll
                for (int e = 0; e < 8; ++e) { lw[e] = 0.f; rr[e] = 0.f; kp[e] = 0.f; vr[e] = 0.f; av[e] = 0.f; bv[e] = 0.f; } }
            if (cgp == 0 && valid) BON[((size_t)b * (NCH * 64) + pos) * NHEAD + h] = bon;
#pragma unroll
            for (int e = 0; e < 8; ++e) LW[i * 64 + c0 + e] = lw[e];
        }
        __syncthreads();
        {
            const int ch = tid & 63, sg = tid >> 6; float s = 0.f;
#pragma unroll
            for (int u = 0; u < 8; ++u) { s += LW[(sg * 8 + u) * 64 + ch]; LW[(sg * 8 + u) * 64 + ch] = s; }
            SEG[sg * 64 + ch] = s;
            __syncthreads();
            float pre = 0.f;
            for (int g = 0; g < sg; ++g) pre += SEG[g * 64 + ch];
#pragma unroll
            for (int u = 0; u < 8; ++u) LW[(sg * 8 + u) * 64 + ch] += pre;
        }
        __syncthreads();
        {
            float at[8], rt[8], bt[8], kt[8];
#pragma unroll
            for (int e = 0; e < 8; ++e) {
                const float Lc = LW[i * 64 + c0 + e], Lt = LW[63 * 64 + c0 + e];
                const float eL = __expf(Lc), eLex = __expf(Lc - lw[e]), einv = __expf(-Lc), eh = __expf(Lt - Lc);
                at[e] = av[e] * eLex; rt[e] = rr[e] * eL; bt[e] = bv[e] * einv; kt[e] = kp[e] * einv;
                st_bf(lds + L_BHT, c0 + e, i, bv[e] * eh); st_bf(lds + L_KHT, c0 + e, i, kp[e] * eh); st_bf(lds + L_VT, c0 + e, i, vr[e]);
                if (i == 63) GC[c0 + e] = eL;
            }
            *(v4u*)(lds + L_AT + i * LP + c0 * 2) = pack8(at); *(v4u*)(lds + L_RT + i * LP + c0 * 2) = pack8(rt);
            *(v4u*)(lds + L_BT + i * LP + c0 * 2) = pack8(bt); *(v4u*)(lds + L_KT + i * LP + c0 * 2) = pack8(kt);
        }
        __syncthreads();
        {
            float atf[8]; unpack8(*(const v4u*)(lds + L_AT + i * LP + c0 * 2), atf);
#pragma unroll
            for (int e = 0; e < 8; ++e) RHS[i * 128 + c0 + e] = atf[e];
        }
        {
            f32x4 aab[2], aak[2], arb[2], ark[2];
#pragma unroll
            for (int t = 0; t < 2; ++t) { aab[t] = (f32x4){0.f, 0.f, 0.f, 0.f}; aak[t] = aab[t]; arb[t] = aab[t]; ark[t] = aab[t]; }
#pragma unroll
            for (int s = 0; s < 2; ++s) {
                const bf16x8 fa = ldfrag(lds + L_AT, tm * 16 + r16, s, q), fr_ = ldfrag(lds + L_RT, tm * 16 + r16, s, q);
#pragma unroll
                for (int t = 0; t < 2; ++t) {
                    const bf16x8 fb = ldfrag(lds + L_BT, (tn0 + t) * 16 + r16, s, q), fk = ldfrag(lds + L_KT, (tn0 + t) * 16 + r16, s, q);
                    aab[t] = MFMA16(fa, fb, aab[t]); aak[t] = MFMA16(fa, fk, aak[t]); arb[t] = MFMA16(fr_, fb, arb[t]); ark[t] = MFMA16(fr_, fk, ark[t]);
                }
            }
#pragma unroll
            for (int t = 0; t < 2; ++t)
#pragma unroll
                for (int jj = 0; jj < 4; ++jj) {
                    const int ri = tm * 16 + 4 * q + jj, cj = (tn0 + t) * 16 + r16;
                    AAB[ri * AABP + cj] = cj < ri ? aab[t][jj] : 0.f;
                    st_bf(lds + L_AAK, ri, cj, cj < ri ? aak[t][jj] : 0.f);
                    st_bf(lds + L_ARB, ri, cj, cj <= ri ? arb[t][jj] : 0.f);
                    st_bf(lds + L_ARK, ri, cj, cj <= ri ? ark[t][jj] : 0.f);
                }
        }
        __syncthreads();
        f32x4 y1a[2], nna[2];
        {
            f32x4 ga[2];
#pragma unroll
            for (int t = 0; t < 2; ++t) { ga[t] = (f32x4){0.f, 0.f, 0.f, 0.f}; y1a[t] = ga[t]; nna[t] = ga[t]; }
#pragma unroll
            for (int s = 0; s < 2; ++s) {
                const bf16x8 fak = ldfrag(lds + L_AAK, tm * 16 + r16, s, q), frk = ldfrag(lds + L_ARK, tm * 16 + r16, s, q), fkh = ldfrag(lds + L_KHT, tm * 16 + r16, s, q);
#pragma unroll
                for (int t = 0; t < 2; ++t) {
                    const bf16x8 fv = ldfrag(lds + L_VT, (tn0 + t) * 16 + r16, s, q);
                    ga[t] = MFMA16(fak, fv, ga[t]); y1a[t] = MFMA16(frk, fv, y1a[t]); nna[t] = MFMA16(fkh, fv, nna[t]);
                }
            }
#pragma unroll
            for (int t = 0; t < 2; ++t)
#pragma unroll
                for (int jj = 0; jj < 4; ++jj) RHS[(tm * 16 + 4 * q + jj) * 128 + 64 + (tn0 + t) * 16 + r16] = ga[t][jj];
        }
        __syncthreads();
        if (tid < 128) {
            const int colx = tid;
#pragma unroll 1
            for (int ib = 0; ib < 4; ++ib) {
                float acc[16];
#pragma unroll
                for (int r = 0; r < 16; ++r) acc[r] = RHS[(16 * ib + r) * 128 + colx];
#pragma unroll 1
                for (int j4 = 0; j4 < 4 * ib; ++j4) {
                    const float x0 = RHS[(4 * j4 + 0) * 128 + colx], x1 = RHS[(4 * j4 + 1) * 128 + colx], x2 = RHS[(4 * j4 + 2) * 128 + colx], x3 = RHS[(4 * j4 + 3) * 128 + colx];
#pragma unroll
                    for (int r = 0; r < 16; ++r) { const f32x4 a4 = *(const f32x4*)(AAB + (16 * ib + r) * AABP + 4 * j4);
                        acc[r] = fmaf(a4.x, x0, acc[r]); acc[r] = fmaf(a4.y, x1, acc[r]); acc[r] = fmaf(a4.z, x2, acc[r]); acc[r] = fmaf(a4.w, x3, acc[r]); }
                }
#pragma unroll
                for (int r = 1; r < 16; ++r) {
#pragma unroll
                    for (int j4 = 0; j4 < 4; ++j4) {
                        if (4 * j4 < r) { const f32x4 a4 = *(const f32x4*)(AAB + (16 * ib + r) * AABP + 16 * ib + 4 * j4);
                            if (4 * j4 + 0 < r) acc[r] = fmaf(a4.x, acc[4 * j4 + 0], acc[r]);
                            if (4 * j4 + 1 < r) acc[r] = fmaf(a4.y, acc[4 * j4 + 1], acc[r]);
                            if (4 * j4 + 2 < r) acc[r] = fmaf(a4.z, acc[4 * j4 + 2], acc[r]);
                            if (4 * j4 + 3 < r) acc[r] = fmaf(a4.w, acc[4 * j4 + 3], acc[r]); }
                    }
                }
#pragma unroll
                for (int r = 0; r < 16; ++r) RHS[(16 * ib + r) * 128 + colx] = acc[r];
            }
#pragma unroll
            for (int j8 = 0; j8 < 8; ++j8) { float o[8];
#pragma unroll
                for (int e = 0; e < 8; ++e) o[e] = RHS[(j8 * 8 + e) * 128 + colx];
                *(v4u*)(lds + L_XT + colx * LP + j8 * 16) = pack8(o); }
        }
        __syncthreads();
        f32x4 qa[2], ma[2];
        {
#pragma unroll
            for (int t = 0; t < 2; ++t) { qa[t] = (f32x4){0.f, 0.f, 0.f, 0.f}; ma[t] = qa[t]; }
#pragma unroll
            for (int s = 0; s < 2; ++s) {
                const bf16x8 frb = ldfrag(lds + L_ARB, tm * 16 + r16, s, q), fbh = ldfrag(lds + L_BHT, tm * 16 + r16, s, q);
#pragma unroll
                for (int t = 0; t < 2; ++t) {
                    const bf16x8 fw = ldfrag(lds + L_XT, (tn0 + t) * 16 + r16, s, q), fu = ldfrag(lds + L_XT, 64 + (tn0 + t) * 16 + r16, s, q);
                    qa[t] = MFMA16(frb, fw, qa[t]); y1a[t] = MFMA16(frb, fu, y1a[t]); ma[t] = MFMA16(fbh, fw, ma[t]); nna[t] = MFMA16(fbh, fu, nna[t]);
                }
            }
#pragma unroll
            for (int t = 0; t < 2; ++t)
#pragma unroll
                for (int jj = 0; jj < 4; ++jj) {
                    const int ri = tm * 16 + 4 * q + jj, cj = (tn0 + t) * 16 + r16;
                    qa[t][jj] += bf2f(*(const bf16*)(lds + L_RT + ri * LP + cj * 2));
                    if (ri == cj) ma[t][jj] += GC[ri];
                }
        }
        __syncthreads();
#pragma unroll
        for (int t = 0; t < 2; ++t)
#pragma unroll
            for (int jj = 0; jj < 4; ++jj) {
                const int ri = tm * 16 + 4 * q + jj, cj = (tn0 + t) * 16 + r16;
                st_bf(lds + L_SQ, ri, cj, qa[t][jj]); st_bf(lds + L_SM, ri, cj, ma[t][jj]); st_bf(lds + L_SN, ri, cj, nna[t][jj]); st_bf(lds + L_SY, ri, cj, y1a[t][jj]);
            }
        __syncthreads();
        {
            const int fi = tid >> 6, mt = fi >> 1, s = fi & 1; const int srow = 16 * mt + r16;
            const v2u q0 = *(const v2u*)(lds + L_SQ + srow * LP + (32 * s + 4 * q) * 2), q1 = *(const v2u*)(lds + L_SQ + srow * LP + (32 * s + 16 + 4 * q) * 2);
            const v2u m0 = *(const v2u*)(lds + L_SM + srow * LP + (32 * s + 4 * q) * 2), m1 = *(const v2u*)(lds + L_SM + srow * LP + (32 * s + 16 + 4 * q) * 2);
            *(v4u*)(ws + WS_QF + (size_t)item * 8192 + tid * 16) = (v4u){q0.x, q0.y, q1.x, q1.y};
            *(v4u*)(ws + WS_MF + (size_t)item * 8192 + tid * 16) = (v4u){m0.x, m0.y, m1.x, m1.y};
            const int g4 = (tid >> 6) & 3; float o[16];
            if (tid < 256) {
#pragma unroll
                for (int m2 = 0; m2 < 4; ++m2)
#pragma unroll
                    for (int jj = 0; jj < 4; ++jj) o[m2 * 4 + jj] = bf2f(*(const bf16*)(lds + L_SN + (16 * m2 + 4 * q + jj) * LP + (16 * g4 + r16) * 2));
            } else {
#pragma unroll
                for (int v2 = 0; v2 < 4; ++v2)
#pragma unroll
                    for (int jj = 0; jj < 4; ++jj) o[v2 * 4 + jj] = bf2f(*(const bf16*)(lds + L_SY + (16 * g4 + 4 * q + jj) * LP + (16 * v2 + r16) * 2));
            }
            v4u w0, w1; w0.x = pk2(o[0], o[1]); w0.y = pk2(o[2], o[3]); w0.z = pk2(o[4], o[5]); w0.w = pk2(o[6], o[7]); w1.x = pk2(o[8], o[9]); w1.y = pk2(o[10], o[11]); w1.z = pk2(o[12], o[13]); w1.w = pk2(o[14], o[15]);
            unsigned char* dst = ws + (tid < 256 ? WS_NB : WS_Y1) + (size_t)item * 8192 + (size_t)(g4 * 64 + lane) * 32;
            *(v4u*)dst = w0; *(v4u*)(dst + 16) = w1;
        }
        __syncthreads();
    }
}
DI void phase_c2(const Args& A, int bh, int vs, int lane) {
    unsigned char* ws = A.ws;
    const int b = bh >> 4, h = bh & 15;
    f32x4 Hs[4];
#pragma unroll
    for (int m = 0; m < 4; ++m) Hs[m] = (f32x4){0.f, 0.f, 0.f, 0.f};
    v4u mf[4][2], nb0, nb1;
    {
        const size_t item = (size_t)(b * NCH + 0) * 16 + h;
#pragma unroll
        for (int m = 0; m < 4; ++m)
#pragma unroll
            for (int s = 0; s < 2; ++s) mf[m][s] = *(const v4u*)(ws + WS_MF + item * 8192 + (size_t)((m * 2 + s) * 64 + lane) * 16);
        nb0 = *(const v4u*)(ws + WS_NB + item * 8192 + (size_t)(vs * 64 + lane) * 32); nb1 = *(const v4u*)(ws + WS_NB + item * 8192 + (size_t)(vs * 64 + lane) * 32 + 16);
    }
    for (int c = 0; c < NCH; ++c) {
        const size_t item = (size_t)(b * NCH + c) * 16 + h;
        v4u hw[2];
#pragma unroll
        for (int s = 0; s < 2; ++s) { hw[s].x = pk2(Hs[2 * s][0], Hs[2 * s][1]); hw[s].y = pk2(Hs[2 * s][2], Hs[2 * s][3]); hw[s].z = pk2(Hs[2 * s + 1][0], Hs[2 * s + 1][1]); hw[s].w = pk2(Hs[2 * s + 1][2], Hs[2 * s + 1][3]);
            *(v4u*)(ws + WS_HST + item * 8192 + (size_t)((vs * 2 + s) * 64 + lane) * 16) = hw[s]; }
        if (c == NCH - 1) break;
        v4u mfn[4][2], nbn0, nbn1;
        {
            const size_t itn = item + 16;
#pragma unroll
            for (int m = 0; m < 4; ++m)
#pragma unroll
                for (int s = 0; s < 2; ++s) mfn[m][s] = *(const v4u*)(ws + WS_MF + itn * 8192 + (size_t)((m * 2 + s) * 64 + lane) * 16);
            nbn0 = *(const v4u*)(ws + WS_NB + itn * 8192 + (size_t)(vs * 64 + lane) * 32); nbn1 = *(const v4u*)(ws + WS_NB + itn * 8192 + (size_t)(vs * 64 + lane) * 32 + 16);
        }
        float nf[16]; { float t0[8], t1[8]; unpack8(nb0, t0); unpack8(nb1, t1);
#pragma unroll
            for (int e = 0; e < 8; ++e) { nf[e] = t0[e]; nf[8 + e] = t1[e]; } }
#pragma unroll
        for (int m = 0; m < 4; ++m) {
            f32x4 acc = (f32x4){nf[m * 4], nf[m * 4 + 1], nf[m * 4 + 2], nf[m * 4 + 3]};
#pragma unroll
            for (int s = 0; s < 2; ++s) acc = MFMA16(__builtin_bit_cast(bf16x8, mf[m][s]), __builtin_bit_cast(bf16x8, hw[s]), acc);
            Hs[m] = acc;
        }
#pragma unroll
        for (int m = 0; m < 4; ++m)
#pragma unroll
            for (int s = 0; s < 2; ++s) mf[m][s] = mfn[m][s];
        nb0 = nbn0; nb1 = nbn1;
    }
}
DI void phase_c3(const Args& A, int bx, int G, int wave, int lane) {
    unsigned char* ws = A.ws;
    const bf16* ZR = (const bf16*)(ws + WS_ZR); const bf16* LOG = (const bf16*)(ws + WS_LOG); const float* BON = (const float*)(ws + WS_BON); bf16* YA = (bf16*)(ws + WS_BUFA);
    const float* mu = A.in[5]; const float* lnw = A.in[14]; const float* lnb = A.in[15];
    const int half = wave >> 2, mt = wave & 3, n = lane & 15, q = lane >> 4;
    for (int item = bx * 2 + half; item < NITEM; item += 2 * G) {
        const int h = item & 15, bc = item >> 4, c = bc % NCH, b = bc / NCH;
        f32x4 acc[4];
        {
            const v4u y0 = *(const v4u*)(ws + WS_Y1 + (size_t)item * 8192 + (size_t)(mt * 64 + lane) * 32), y1 = *(const v4u*)(ws + WS_Y1 + (size_t)item * 8192 + (size_t)(mt * 64 + lane) * 32 + 16);
            float t0[8], t1[8]; unpack8(y0, t0); unpack8(y1, t1);
            acc[0] = (f32x4){t0[0], t0[1], t0[2], t0[3]}; acc[1] = (f32x4){t0[4], t0[5], t0[6], t0[7]}; acc[2] = (f32x4){t1[0], t1[1], t1[2], t1[3]}; acc[3] = (f32x4){t1[4], t1[5], t1[6], t1[7]};
        }
#pragma unroll
        for (int s = 0; s < 2; ++s) {
            const v4u qf = *(const v4u*)(ws + WS_QF + (size_t)item * 8192 + (size_t)((mt * 2 + s) * 64 + lane) * 16);
#pragma unroll
            for (int vs = 0; vs < 4; ++vs) {
                const v4u hf = *(const v4u*)(ws + WS_HST + (size_t)item * 8192 + (size_t)((vs * 2 + s) * 64 + lane) * 16);
                acc[vs] = MFMA16(__builtin_bit_cast(bf16x8, qf), __builtin_bit_cast(bf16x8, hf), acc[vs]);
            }
        }
        float lw_[4], lb_[4], mv_[4];
#pragma unroll
        for (int vs = 0; vs < 4; ++vs) { const int col = h * 64 + vs * 16 + n; lw_[vs] = lnw[col]; lb_[vs] = lnb[col]; mv_[vs] = mu[2048 + col]; }
#pragma unroll
        for (int jj = 0; jj < 4; ++jj) {
            float s1 = (acc[0][jj] + acc[1][jj]) + (acc[2][jj] + acc[3][jj]);
            s1 += __shfl_xor(s1, 1); s1 += __shfl_xor(s1, 2); s1 += __shfl_xor(s1, 4); s1 += __shfl_xor(s1, 8);
            const float mean = s1 * (1.0f / 64.0f);
            float d[4], s2 = 0.f;
#pragma unroll
            for (int vs = 0; vs < 4; ++vs) { d[vs] = acc[vs][jj] - mean; s2 += d[vs] * d[vs]; }
            s2 += __shfl_xor(s2, 1); s2 += __shfl_xor(s2, 2); s2 += __shfl_xor(s2, 4); s2 += __shfl_xor(s2, 8);
            const float rstd = 1.0f / sqrtf(s2 * (1.0f / 64.0f) + GN_EPS);
            const int i = 16 * mt + 4 * q + jj, pos = c * 64 + i;
            if (pos < LSEQ && (pos >= NMETA || b == 0)) {
                const int row = pos < NMETA ? MX + pos : b * SEQ + pos - NMETA, prow = prev_row(row);
                const float bon = BON[((size_t)b * (NCH * 64) + pos) * NHEAD + h];
#pragma unroll
                for (int vs = 0; vs < 4; ++vs) {
                    const int col = h * 64 + vs * 16 + n;
                    const float vv = bf2f(ZR[(size_t)row * ZR_LD + 2048 + col]), vp = prow >= 0 ? bf2f(ZR[(size_t)prow * ZR_LD + 2048 + col]) : 0.f;
                    const float vsh = vv + (vp - vv) * mv_[vs];
                    const float g = bf2f(LOG[(size_t)row * 1024 + col]);
                    const float y = (d[vs] * rstd * lw_[vs] + lb_[vs] + bon * vsh) * g;
                    YA[(size_t)row * DM + 1024 + col] = (bf16)f2bf(y);
                }
            }
        }
    }
}
DI void phase4(const Args& A, int gw, int NGW, int lane) {
    unsigned char* ws = A.ws;
    const float* MIX = (const float*)(ws + WS_MIX); const float* MIXM = (const float*)(ws + WS_MIXM); bf16* N2 = (bf16*)(ws + WS_BUFA); bf16* N2M = (bf16*)(ws + WS_N2M);
    const f32x4* g1 = (const f32x4*)A.in[17] + lane; const f32x4* g2 = (const f32x4*)A.in[18] + lane;
    for (int m = gw; m < MX + 2; m += NGW) {
        const f32x4* hr = (const f32x4*)(m < MX ? A.in[0] + (size_t)m * DM : A.in[1] + (size_t)(14 + m - MX) * DM) + lane;
        const f32x4* mr = (const f32x4*)(m < MX ? MIX + (size_t)m * DM : MIXM + (size_t)(m - MX) * DM) + lane;
        f32x4 v[8]; float s = 0.f;
#pragma unroll
        for (int j = 0; j < 8; ++j) { v[j] = mr[64 * j]; s += (v[j].x * v[j].x + v[j].y * v[j].y) + (v[j].z * v[j].z + v[j].w * v[j].w); }
        const float rs = 1.0f / sqrtf(wave_sum(s) * (1.0f / DM) + RMS_EPS);
        float s2 = 0.f;
#pragma unroll
        for (int j = 0; j < 8; ++j) { const f32x4 g = g1[64 * j], hh = hr[64 * j]; v[j] = hh + v[j] * rs * g; s2 += (v[j].x * v[j].x + v[j].y * v[j].y) + (v[j].z * v[j].z + v[j].w * v[j].w); }
        const float rs2 = 1.0f / sqrtf(wave_sum(s2) * (1.0f / DM) + RMS_EPS);
        if (m < MX) { f32x4* orow = (f32x4*)(A.out + (size_t)m * DM) + lane;
#pragma unroll
            for (int j = 0; j < 8; ++j) orow[64 * j] = v[j]; }
        v2u* o8 = (v2u*)(m < MX ? N2 + (size_t)m * DM : N2M + (size_t)(m - MX) * DM) + lane;
#pragma unroll
        for (int j = 0; j < 8; ++j) { const f32x4 g = g2[64 * j]; o8[64 * j] = (v2u){pk2(v[j].x * rs2 * g.x, v[j].y * rs2 * g.y), pk2(v[j].z * rs2 * g.z, v[j].w * rs2 * g.w)}; }
    }
}
DI void phase6(const Args& A, int gtid, int NT) {
    unsigned char* ws = A.ws;
    const float* G4 = (const float*)(ws + WS_G4); const float* U2 = (const float*)(ws + WS_U2); const float* GM = (const float*)(ws + WS_GM); bf16* ACT = (bf16*)(ws + WS_ACT);
    const float* cw = A.in[20];
    constexpr int C4 = DFF / 4;
    for (int idx = gtid; idx < 256 * 2 * C4; idx += NT) {
        const int c4 = idx % C4, lr = (idx / C4) & 1, rb = idx / (2 * C4), col = c4 * 4;
        const f32x4 g0 = *(const f32x4*)(G4 + (size_t)(rb * 4 + lr) * DFF + col);
        const float* pm2; const float* pm1;
        const float* pb62 = (rb % 128 == 0) ? GM + col : G4 + (size_t)((rb - 1) * 4 + 2) * DFF + col;
        const float* pb63 = (rb % 128 == 0) ? GM + DFF + col : G4 + (size_t)((rb - 1) * 4 + 3) * DFF + col;
        if (lr == 0) { pm2 = pb62; pm1 = pb63; } else { pm2 = pb63; pm1 = G4 + (size_t)(rb * 4 + 0) * DFF + col; }
        const f32x4 gm2 = *(const f32x4*)pm2, gm1 = *(const f32x4*)pm1, up = *(const f32x4*)(U2 + (size_t)(rb * 2 + lr) * DFF + col);
        const f32x4 w0 = *(const f32x4*)(cw + col), w1 = *(const f32x4*)(cw + DFF + col), w2 = *(const f32x4*)(cw + 2 * DFF + col);
        float o[4];
#pragma unroll
        for (int x = 0; x < 4; ++x) { const float cv = w0[x] * gm2[x] + w1[x] * gm1[x] + w2[x] * g0[x]; o[x] = cv / (1.0f + __expf(-cv)) * up[x]; }
        *(v2u*)(ACT + (size_t)(rb * 64 + lr) * DFF + col) = (v2u){pk2(o[0], o[1]), pk2(o[2], o[3])};
    }
}
DI void phase8(const Args& A, int gw, int NGW, int lane) {
    const float* F = (const float*)(A.ws + WS_F); const f32x4* g = (const f32x4*)A.in[22] + lane;
    for (int m = gw; m < MX; m += NGW) {
        const f32x4* fr = (const f32x4*)(F + (size_t)m * DM) + lane; f32x4* orow = (f32x4*)(A.out + (size_t)m * DM) + lane;
        f32x4 v[8]; float s = 0.f;
#pragma unroll
        for (int j = 0; j < 8; ++j) { v[j] = fr[64 * j]; s += (v[j].x * v[j].x + v[j].y * v[j].y) + (v[j].z * v[j].z + v[j].w * v[j].w); }
        const float rs = 1.0f / sqrtf(wave_sum(s) * (1.0f / DM) + RMS_EPS);
#pragma unroll
        for (int j = 0; j < 8; ++j) orow[64 * j] = orow[64 * j] + v[j] * rs * g[64 * j];
    }
}
__global__ void __launch_bounds__(NTHR, 2) hymba_fwd(Args args) {
    extern __shared__ __attribute__((aligned(16))) unsigned char lds[];
    cg::grid_group grid = cg::this_grid();
    const int tid = threadIdx.x, lane = tid & 63, wave = __builtin_amdgcn_readfirstlane(tid >> 6);
    const int G = gridDim.x, bx = blockIdx.x;
    const int gw = bx * NWAVES + wave, NGW = G * NWAVES;
    unsigned char* ws = args.ws;
    PG8_LAS unsigned char* ldsg = (PG8_LAS unsigned char*)lds;

    phase0(args, lds, gw, NGW, wave, lane);
    grid.sync();
    {
        pg8::Gemm g{(const bf16*)(ws + WS_BUFA), (const bf16*)(ws + WS_WIN), MP, IN_PAD, DM}; pg8::StaticOrder S; S.init(MP, IN_PAD, G, bx);
        pg8::EpiSplit2 E{(bf16*)(ws + WS_ZC), ZC_LD, (bf16*)(ws + WS_ZR), ZR_LD, ZC_LD};
        pg8::gemm_phase<pg8::EpiSplit2, pg8::StaticOrder, true, true>(ldsg, g, S, E);
    }
    grid.sync();
    phase2a(args, gw, NGW, lane);
    grid.sync();
    {
        pg8::Gemm g{(const bf16*)(ws + WS_LA), (const bf16*)(ws + WS_WLORA), MP, 3072, 512}; pg8::StaticOrder S; S.init(MP, 3072, G, bx);
        pg8::EpiSplit2 E{(bf16*)(ws + WS_LODA), 2048, (bf16*)(ws + WS_LOG), 1024, 2048};
        pg8::gemm_phase<pg8::EpiSplit2, pg8::StaticOrder, true, true>(ldsg, g, S, E);
    }
    grid.sync();
    phase_c1(args, lds, bx, G, tid, wave, lane);
    grid.sync();
    if (bx < 32) { if (wave < 4) phase_c2(args, bx, wave, lane); }
    else convert_late(args, lds, (bx - 32) * NWAVES + wave, (G - 32) * NWAVES, wave, lane);
    grid.sync();
    phase_c3(args, bx, G, wave, lane);
    grid.sync();
    {
        const bf16* YA = (const bf16*)(ws + WS_BUFA); const bf16* WOUT = (const bf16*)(ws + WS_WOUT); float* MIXM = (float*)(ws + WS_MIXM);
        for (int n = gw; n < DM; n += NGW) { float o0, o1; gemv2(YA + (size_t)(MX + 14) * DM, YA + (size_t)(MX + 15) * DM, WOUT + (size_t)n * DM, DM, lane, o0, o1); if (lane == 0) { MIXM[n] = o0; MIXM[DM + n] = o1; } }
        pg8::Gemm g{YA, WOUT, MX, DM, DM}; pg8::StaticOrder S; S.init(MX, DM, G, bx);
        pg8::EpiF32 E{(float*)(ws + WS_MIX), DM};
        pg8::gemm_phase<pg8::EpiF32, pg8::StaticOrder, true, true>(ldsg, g, S, E);
    }
    grid.sync();
    phase4(args, gw, NGW, lane);
    grid.sync();
    {
        const bf16* N2 = (const bf16*)(ws + WS_BUFA); const bf16* N2M = (const bf16*)(ws + WS_N2M); const bf16* WGU = (const bf16*)(ws + WS_WGU); float* GM = (float*)(ws + WS_GM);
        for (int j = gw; j < DFF; j += NGW) { float o0, o1; gemv2(N2M, N2M + DM, WGU + (size_t)(256 * (j >> 7) + (j & 127)) * DM, DM, lane, o0, o1); if (lane == 0) { GM[j] = o0; GM[DFF + j] = o1; } }
        pg8::Gemm g{N2, WGU, MX, 2 * DFF, DM}; pg8::StaticOrder S; S.init(MX, 2 * DFF, G, bx);
        pg8::EpiAct E{(bf16*)(ws + WS_ACT), (float*)(ws + WS_G4), (float*)(ws + WS_U2), args.in[20], DFF};
        pg8::gemm_phase<pg8::EpiAct, pg8::StaticOrder, true, true>(ldsg, g, S, E);
    }
    grid.sync();
    phase6(args, bx * NTHR + tid, G * NTHR);
    grid.sync();
    {
        pg8::Gemm g{(const bf16*)(ws + WS_ACT), (const bf16*)(ws + WS_WDN), MX, DM, DFF}; pg8::StaticOrder S; S.init(MX, DM, G, bx);
        pg8::EpiF32 E{(float*)(ws + WS_F), DM};
        pg8::gemm_phase<pg8::EpiF32, pg8::StaticOrder, true, true>(ldsg, g, S, E);
    }
    grid.sync();
    phase8(args, gw, NGW, lane);
}

extern "C" void kernel_launch(void* const* d_in, const int* in_sizes, int n_in, void* d_out, int out_size, void* d_ws, size_t ws_size, hipStream_t stream) {
    static int grid = 0;
    if (grid == 0) {
        if (n_in != 23 || out_size != MX * DM || ws_size < WS_END) { fprintf(stderr, "kernel_launch: unexpected shapes (n_in %d, out %d, ws %zu)\n", n_in, out_size, ws_size); grid = -1; return; }
        int dev = 0, cus = 0, per_cu = 0;
        if (hipGetDevice(&dev) != hipSuccess || hipDeviceGetAttribute(&cus, hipDeviceAttributeMultiprocessorCount, dev) != hipSuccess) { grid = -1; return; }
        if (hipFuncSetAttribute((const void*)hymba_fwd, hipFuncAttributeMaxDynamicSharedMemorySize, LDS_BYTES) != hipSuccess) { fprintf(stderr, "kernel_launch: hipFuncSetAttribute failed\n"); grid = -1; return; }
        if (hipOccupancyMaxActiveBlocksPerMultiprocessor(&per_cu, (const void*)hymba_fwd, NTHR, LDS_BYTES) != hipSuccess || per_cu < 1) { fprintf(stderr, "kernel_launch: occupancy query says %d\n", per_cu); per_cu = 1; }
        (void)hipGetLastError();
        grid = cus * 1;
        if (grid < 64) { grid = -1; return; }
    }
    if (grid < 0) return;
    Args a{};
    for (int i = 0; i < 23; ++i) a.in[i] = (const float*)d_in[i];
    a.out = (float*)d_out; a.ws = (unsigned char*)d_ws;
    void* kargs[] = {&a};
    hipError_t e = hipLaunchCooperativeKernel((const void*)hymba_fwd, dim3(grid), dim3(NTHR), kargs, LDS_BYTES, stream);
    if (e != hipSuccess) fprintf(stderr, "kernel_launch: cooperative launch failed: %s (grid %d)\n", hipGetErrorString(e), grid);
}
```

```cpp
#include <hip/hip_runtime.h>
#include <hip/hip_cooperative_groups.h>
#include <cstdio>
#include <cstdint>
namespace cg = cooperative_groups;
namespace pg8 {
#define PG8_LAS __attribute__((address_space(3)))
typedef unsigned short bf16_t;
typedef short bf16x8 __attribute__((ext_vector_type(8)));
typedef float f32x4 __attribute__((ext_vector_type(4)));
typedef unsigned u32x4 __attribute__((ext_vector_type(4)));
constexpr int BM = 256, BK = 64, HALF = 128, HTB = HALF * BK * 2  , STAGE_BYTES = 8 * HTB, NXCD = 8, WGM = 8;

__host__ __device__ __forceinline__ int lds_byte(int r, int c) { const int st = (r >> 4) * 2 + (c >> 5), rr = r & 15, cc = c & 31, ob = rr * 64 + cc * 2; return st * 1024 + (ob ^ (((ob >> 9) & 1) << 5)); }
__host__ __device__ __forceinline__ void stage_rc(int b, int& R, int& C) { const int st = b / 1024, sb = b % 1024, swz = sb ^ (((sb >> 9) & 1) << 5); R = (st >> 1) * 16 + swz / 64; C = (st & 1) * 32 + (swz % 64) / 2; }
__host__ __device__ __forceinline__ int perm32(int rho) { const int n = rho >> 4, i = rho & 15; return 8 * (i >> 2) + 4 * n + (i & 3); }

struct Unit { int pm, pn; };
struct Gemm { const bf16_t* A; const bf16_t* Bt; int M, N, K, lda, ldb; };

struct StaticOrder {
    int nM, nN, nwg, G, c;
    __host__ __device__ void init(int M, int N, int G_, int c_) { nM = M / BM; nN = N / BM; nwg = nM * nN; G = G_; c = c_; }
    __host__ __device__ bool next(int i, Unit& u) const {
        const long L = (long)i * G + c; if (L >= nwg) return false;
        int wgid = (int)L; { const int q = nwg / NXCD, r = nwg % NXCD, xcd = wgid % NXCD, off = wgid / NXCD; wgid = (xcd < r ? xcd * (q + 1) : r * (q + 1) + (xcd - r) * q) + off; }
        const int nig = WGM * nN, gid = wgid / nig, fm = gid * WGM, gsz = (nM - fm) < WGM ? (nM - fm) : WGM;
        u.pm = fm + ((wgid % nig) % gsz); u.pn = (wgid % nig) / gsz; return true;
    }
    __device__ __forceinline__ void a_ready(const Unit&) const {}
    __device__ __forceinline__ void done(const Unit&) const {}
};
__device__ __forceinline__ unsigned cvt_pk_bf16(float lo, float hi) { unsigned r; asm volatile("v_cvt_pk_bf16_f32 %0, %1, %2" : "=v"(r) : "v"(lo), "v"(hi)); return r; }
template <class Epi, class Sched, bool ALIGN_EPI = false, bool SP2 = false>
__device__ __forceinline__ void gemm_phase(PG8_LAS unsigned char* lds, const Gemm g, const Sched& S, const Epi& E) {
    int tid_ = threadIdx.x; asm volatile("" : "+v"(tid_));
    const int tid = tid_, wid = __builtin_amdgcn_readfirstlane(tid >> 6), lane = tid & 63, wr = wid >> 2, wc = wid & 3, fr = lane & 15, fq = lane >> 4;
    const int K = g.K, nt = K / BK;
    unsigned voffA[2], voffB[2];
#pragma unroll
    for (int i = 0; i < 2; ++i) { int R, C; stage_rc(tid * 16 + i * 8192, R, C); const int Rb = Epi::PERM ? ((R & ~31) + perm32(R & 31)) : R;
        voffA[i] = (unsigned)(R * g.lda + C) * 2u; voffB[i] = (unsigned)(Rb * g.ldb + C) * 2u; }
    const size_t kstep = (size_t)(BK * 2);
    const size_t hstepA = (size_t)HALF * g.lda * 2, hstepB = (size_t)HALF * g.ldb * 2;
    const size_t tstepA = 2 * hstepA, tstepB = 2 * hstepB;
    const unsigned ldsw = (unsigned)wid * 1024u;
    const int aoff = lds_byte(wr * 64 + fr, fq * 8), boff = lds_byte(wc * 32 + fr, fq * 8);
#define PG8_SA(b, h) (((b) * 2 + (h)) * HTB)
#define PG8_SB(b, h) ((4 + (b) * 2 + (h)) * HTB)
#define PG8_STAGE(bufoff, gbase, voff) do { _Pragma("unroll") for (int _i = 0; _i < 2; ++_i) \
        __builtin_amdgcn_global_load_lds((const unsigned*)((const char*)(gbase) + (voff)[_i]), (PG8_LAS unsigned*)(lds + (bufoff) + ldsw + _i * 8192), 16, 0, 0); } while (0)
#define PG8_LDA(dst, b, h) do { _Pragma("unroll") for (int m = 0; m < 4; ++m) _Pragma("unroll") for (int k = 0; k < 2; ++k) dst[m][k] = *(const PG8_LAS bf16x8*)(lds + PG8_SA(b, h) + aoff + m * 2048 + k * 1024); } while (0)
#define PG8_LDB(dst, b, h) do { _Pragma("unroll") for (int n = 0; n < 2; ++n) _Pragma("unroll") for (int k = 0; k < 2; ++k) dst[n][k] = *(const PG8_LAS bf16x8*)(lds + PG8_SB(b, h) + boff + n * 2048 + k * 1024); } while (0)
#define PG8_MMA(ai, bj, At, Bt) do { __builtin_amdgcn_s_setprio(1); _Pragma("unroll") for (int m = 0; m < 4; ++m) _Pragma("unroll") for (int n = 0; n < 2; ++n) _Pragma("unroll") for (int k = 0; k < 2; ++k) \
        acc[ai][bj][m][n] = __builtin_amdgcn_mfma_f32_16x16x32_bf16(Bt[n][k], At[m][k], acc[ai][bj][m][n], 0, 0, 0); __builtin_amdgcn_s_setprio(0); } while (0)
#define PG8_WAIT_V(n) asm volatile("s_waitcnt vmcnt(" #n ")" ::: "memory")
#define PG8_WAIT_L(n) asm volatile("s_waitcnt lgkmcnt(" #n ")" ::: "memory")
#define PG8_BAR __builtin_amdgcn_s_barrier()
#define PG8_SCHED __builtin_amdgcn_sched_barrier(0)
    Unit cur, nxt; int ui = 0;
    if (!S.next(0, cur)) return;
    f32x4 acc[2][2][4][2];
#pragma unroll
    for (int a = 0; a < 2; ++a)
#pragma unroll
        for (int b = 0; b < 2; ++b)
#pragma unroll
            for (int m = 0; m < 4; ++m)
#pragma unroll
                for (int n = 0; n < 2; ++n) acc[a][b][m][n] = (f32x4){0.f, 0.f, 0.f, 0.f};
    bf16x8 At[4][2], B0[2][2], B1[2][2];
    const char* cA = (const char*)g.A + (size_t)cur.pm * tstepA; const char* cB = (const char*)g.Bt + (size_t)cur.pn * tstepB;
    S.a_ready(cur);
    if constexpr (SP2) {
        PG8_STAGE(PG8_SB(0, 0), cB, voffB); PG8_STAGE(PG8_SB(0, 1), cB + hstepB, voffB); PG8_STAGE(PG8_SA(0, 0), cA, voffA); PG8_STAGE(PG8_SA(0, 1), cA + hstepA, voffA);
        if (wr == 1) PG8_BAR;
        PG8_WAIT_V(2); PG8_BAR;
        PG8_STAGE(PG8_SB(1, 0), cB + kstep, voffB); PG8_STAGE(PG8_SA(1, 0), cA + kstep, voffA); PG8_STAGE(PG8_SB(1, 1), cB + hstepB + kstep, voffB);
        PG8_WAIT_V(6); PG8_BAR;
    } else {
        PG8_STAGE(PG8_SB(0, 0), cB, voffB); PG8_STAGE(PG8_SA(0, 0), cA, voffA); PG8_STAGE(PG8_SB(0, 1), cB + hstepB, voffB); PG8_STAGE(PG8_SA(0, 1), cA + hstepA, voffA);
        if (wr == 1) PG8_BAR;
        PG8_WAIT_V(4); PG8_BAR;
        PG8_STAGE(PG8_SB(1, 0), cB + kstep, voffB); PG8_STAGE(PG8_SA(1, 0), cA + kstep, voffA); PG8_STAGE(PG8_SB(1, 1), cB + hstepB + kstep, voffB);
        PG8_WAIT_V(6); PG8_BAR;
    }
    for (;;) {
        const bool has_next = S.next(ui + 1, nxt);
        const char* nA = has_next ? (const char*)g.A + (size_t)nxt.pm * tstepA : cA; const char* nB = has_next ? (const char*)g.Bt + (size_t)nxt.pn * tstepB : cB;
        for (int t = 0; t < nt; t += 2) {
            const bool last = (t == nt - 2);
            const char* a1 = cA + (size_t)(t + 1) * kstep;
            const char* a2 = last ? nA : cA + (size_t)(t + 2) * kstep; const char* b2 = last ? nB : cB + (size_t)(t + 2) * kstep;
            const char* a3 = a2 + kstep; const char* b3 = b2 + kstep;
            if (last && has_next) S.a_ready(nxt);
            if constexpr (SP2) {
            PG8_LDB(B0, 0, 0); PG8_LDB(B1, 0, 1); PG8_SCHED; PG8_LDA(At, 0, 0); PG8_STAGE(PG8_SA(1, 1), a1 + hstepA, voffA);
            PG8_WAIT_V(8); PG8_WAIT_L(0); PG8_BAR; PG8_MMA(0, 0, At, B0); PG8_MMA(0, 1, At, B1); PG8_BAR; PG8_SCHED;
            PG8_LDA(At, 0, 1); PG8_STAGE(PG8_SB(0, 0), b2, voffB); PG8_STAGE(PG8_SB(0, 1), b2 + hstepB, voffB); PG8_STAGE(PG8_SA(0, 0), a2, voffA);
            PG8_WAIT_V(8); PG8_WAIT_L(0); PG8_BAR; PG8_MMA(1, 0, At, B0); PG8_MMA(1, 1, At, B1); PG8_BAR; PG8_SCHED;
            PG8_LDB(B0, 1, 0); PG8_LDB(B1, 1, 1); PG8_SCHED; PG8_LDA(At, 1, 0); PG8_STAGE(PG8_SA(0, 1), a2 + hstepA, voffA);
            PG8_WAIT_V(8); PG8_WAIT_L(0); PG8_BAR; PG8_MMA(0, 0, At, B0); PG8_MMA(0, 1, At, B1); PG8_BAR; PG8_SCHED;
            PG8_LDA(At, 1, 1); PG8_STAGE(PG8_SB(1, 0), b3, voffB); PG8_STAGE(PG8_SB(1, 1), b3 + hstepB, voffB); PG8_STAGE(PG8_SA(1, 0), a3, voffA);
            PG8_WAIT_V(8); PG8_WAIT_L(0); PG8_BAR; PG8_MMA(1, 0, At, B0); PG8_MMA(1, 1, At, B1); PG8_BAR; PG8_SCHED;
            } else {
            PG8_LDB(B0, 0, 0); PG8_SCHED; PG8_LDA(At, 0, 0); PG8_STAGE(PG8_SA(1, 1), a1 + hstepA, voffA);
            PG8_WAIT_L(8); PG8_BAR; PG8_WAIT_L(0); PG8_MMA(0, 0, At, B0); PG8_BAR; PG8_SCHED;
            PG8_LDB(B1, 0, 1); PG8_STAGE(PG8_SB(0, 0), b2, voffB);
            PG8_BAR; PG8_WAIT_L(0); PG8_MMA(0, 1, At, B1); PG8_BAR;
            PG8_LDA(At, 0, 1); PG8_STAGE(PG8_SA(0, 0), a2, voffA);
            PG8_BAR; PG8_WAIT_L(0); PG8_MMA(1, 0, At, B0); PG8_BAR; PG8_SCHED;
            PG8_STAGE(PG8_SB(0, 1), b2 + hstepB, voffB);
            PG8_WAIT_V(6); PG8_BAR; PG8_MMA(1, 1, At, B1); PG8_BAR;
            PG8_LDB(B0, 1, 0); PG8_SCHED; PG8_LDA(At, 1, 0); PG8_STAGE(PG8_SA(0, 1), a2 + hstepA, voffA);
            PG8_WAIT_L(8); PG8_BAR; PG8_WAIT_L(0); PG8_MMA(0, 0, At, B0); PG8_BAR; PG8_SCHED;
            PG8_LDB(B1, 1, 1); PG8_STAGE(PG8_SB(1, 0), b3, voffB);
            PG8_BAR; PG8_WAIT_L(0); PG8_MMA(0, 1, At, B1); PG8_BAR;
            PG8_LDA(At, 1, 1); PG8_STAGE(PG8_SA(1, 0), a3, voffA);
            PG8_BAR; PG8_WAIT_L(0); PG8_MMA(1, 0, At, B0); PG8_BAR; PG8_SCHED;
            PG8_STAGE(PG8_SB(1, 1), b3 + hstepB, voffB);
            PG8_WAIT_V(6); PG8_BAR; PG8_MMA(1, 1, At, B1); PG8_BAR;
            }
        }
        if constexpr (ALIGN_EPI) { if (wr == 0) PG8_BAR; }
        if constexpr (!Epi::AFTER_DRAIN) { E(acc, cur, wr, wc, fr, fq); S.done(cur); }
        if (!has_next) break;
#pragma unroll
        for (int a = 0; a < 2; ++a)
#pragma unroll
            for (int b = 0; b < 2; ++b)
#pragma unroll
                for (int m = 0; m < 4; ++m)
#pragma unroll
                    for (int n = 0; n < 2; ++n) acc[a][b][m][n] = (f32x4){0.f, 0.f, 0.f, 0.f};
        cur = nxt; cA = nA; cB = nB; ++ui;
        if constexpr (ALIGN_EPI) { if (wr == 1) PG8_BAR; }
    }
    PG8_WAIT_V(0);
    if constexpr (!ALIGN_EPI) { if (wr == 0) PG8_BAR; }
    PG8_BAR;
    if constexpr (Epi::AFTER_DRAIN) { E.fused(acc, cur, wr, wc, fr, fq, lds, wid, lane); S.done(cur); }
#undef PG8_SA
#undef PG8_SB
#undef PG8_STAGE
#undef PG8_LDA
#undef PG8_LDB
#undef PG8_MMA
#undef PG8_WAIT_V
#undef PG8_WAIT_L
#undef PG8_BAR
#undef PG8_SCHED
}
struct EpiSplit2 {
    static constexpr bool PERM = true, AFTER_DRAIN = false;
    bf16_t* O0; int ld0; bf16_t* O1; int ld1; int split_col;
    __device__ __forceinline__ void operator()(const f32x4 (&acc)[2][2][4][2], const Unit& u, int wr, int wc, int fr, int fq) const {
        const int row0 = u.pm * BM + wr * 64 + fr; int colt = u.pn * BM; bf16_t* base = O0; int ldc = ld0;
        if (colt >= split_col) { base = O1; ldc = ld1; colt -= split_col; }
        const int col0 = colt + wc * 32 + 8 * fq;
#pragma unroll
        for (int ai = 0; ai < 2; ++ai)
#pragma unroll
            for (int m = 0; m < 4; ++m) { bf16_t* rowp = base + (size_t)(row0 + ai * HALF + m * 16) * ldc + col0;
#pragma unroll
                for (int bj = 0; bj < 2; ++bj) { const f32x4 v0 = acc[ai][bj][m][0], v1 = acc[ai][bj][m][1];
                    u32x4 w; w.x = cvt_pk_bf16(v0[0], v0[1]); w.y = cvt_pk_bf16(v0[2], v0[3]); w.z = cvt_pk_bf16(v1[0], v1[1]); w.w = cvt_pk_bf16(v1[2], v1[3]);
                    *(u32x4*)(rowp + bj * HALF) = w; } }
    }
};
struct EpiF32 {
    static constexpr bool PERM = false, AFTER_DRAIN = false;
    float* C; int ldc;
    __device__ __forceinline__ void operator()(const f32x4 (&acc)[2][2][4][2], const Unit& u, int wr, int wc, int fr, int fq) const {
        const int row0 = u.pm * BM + wr * 64 + fr, col0 = u.pn * BM + wc * 32 + 4 * fq;
#pragma unroll
        for (int ai = 0; ai < 2; ++ai)
#pragma unroll
            for (int m = 0; m < 4; ++m) { float* rowp = C + (size_t)(row0 + ai * HALF + m * 16) * ldc + col0;
#pragma unroll
                for (int bj = 0; bj < 2; ++bj)
#pragma unroll
                    for (int n = 0; n < 2; ++n) *(f32x4*)(rowp + bj * HALF + n * 16) = acc[ai][bj][m][n]; }
    }
};
struct EpiAct {
    static constexpr bool PERM = true, AFTER_DRAIN = false;
    bf16_t* ACT; float* G4; float* U2; const float* cw; int dff;
    __device__ __forceinline__ void operator()(const f32x4 (&acc)[2][2][4][2], const Unit& u, int wr, int wc, int fr, int fq) const {
        const int lane = (int)(threadIdx.x & 63);
        const int colg = u.pn * HALF + wc * 32 + 8 * fq;
        const int src1 = (lane & 48) | ((fr + 15) & 15), src2 = (lane & 48) | ((fr + 14) & 15);
        f32x4 w0[2], w1[2], w2[2];
#pragma unroll
        for (int n = 0; n < 2; ++n) { w0[n] = *(const f32x4*)(cw + colg + 4 * n); w1[n] = *(const f32x4*)(cw + dff + colg + 4 * n); w2[n] = *(const f32x4*)(cw + 2 * dff + colg + 4 * n); }
#pragma unroll
        for (int ai = 0; ai < 2; ++ai) {
            const int rowb = u.pm * BM + ai * HALF + wr * 64;
            const int rb = rowb >> 6;
            f32x4 c1[2], c2[2];
#pragma unroll
            for (int n = 0; n < 2; ++n) { c1[n] = (f32x4){0.f, 0.f, 0.f, 0.f}; c2[n] = c1[n]; }
#pragma unroll
            for (int m = 0; m < 4; ++m) {
                u32x4 wout; unsigned pk[4];
#pragma unroll
                for (int n = 0; n < 2; ++n) {
                    const f32x4 g = acc[ai][0][m][n], up = acc[ai][1][m][n];
                    f32x4 s1, s2, o;
#pragma unroll
                    for (int x = 0; x < 4; ++x) { s1[x] = __shfl(g[x], src1); s2[x] = __shfl(g[x], src2); }
#pragma unroll
                    for (int x = 0; x < 4; ++x) {
                        const float p1 = fr >= 1 ? s1[x] : c1[n][x], p2 = fr >= 2 ? s2[x] : c2[n][x];
                        const float cv = w0[n][x] * p2 + w1[n][x] * p1 + w2[n][x] * g[x];
                        o[x] = cv * __builtin_amdgcn_rcpf(1.0f + __expf(-cv)) * up[x];
                    }
                    c1[n] = s1; c2[n] = s2;
                    pk[2 * n] = cvt_pk_bf16(o[0], o[1]); pk[2 * n + 1] = cvt_pk_bf16(o[2], o[3]);
                    if (m == 0 && fr < 2) { *(f32x4*)(G4 + (size_t)(rb * 4 + fr) * dff + colg + 4 * n) = g; *(f32x4*)(U2 + (size_t)(rb * 2 + fr) * dff + colg + 4 * n) = up; }
                    if (m == 3 && fr >= 14) { *(f32x4*)(G4 + (size_t)(rb * 4 + 2 + (fr - 14)) * dff + colg + 4 * n) = g; }
                }
                wout.x = pk[0]; wout.y = pk[1]; wout.z = pk[2]; wout.w = pk[3];
                *(u32x4*)(ACT + (size_t)(rowb + m * 16 + fr) * dff + colg) = wout;
            }
        }
    }
};
struct EpiAddBf16 {
    static constexpr bool PERM = true, AFTER_DRAIN = false;
    const bf16_t* P; bf16_t* O; int ldc;
    __device__ __forceinline__ void operator()(const f32x4 (&acc)[2][2][4][2], const Unit& u, int wr, int wc, int fr, int fq) const {
        const int row0 = u.pm * BM + wr * 64 + fr, col0 = u.pn * BM + wc * 32 + 8 * fq;
#pragma unroll
        for (int ai = 0; ai < 2; ++ai)
#pragma unroll
            for (int m = 0; m < 4; ++m) { const size_t off = (size_t)(row0 + ai * HALF + m * 16) * ldc + col0;
#pragma unroll
                for (int bj = 0; bj < 2; ++bj) { const f32x4 v0 = acc[ai][bj][m][0], v1 = acc[ai][bj][m][1];
                    const u32x4 p = *(const u32x4*)(P + off + bj * HALF);
                    u32x4 w;
                    w.x = cvt_pk_bf16(v0[0] + __builtin_bit_cast(float, p.x << 16), v0[1] + __builtin_bit_cast(float, p.x & 0xffff0000u));
                    w.y = cvt_pk_bf16(v0[2] + __builtin_bit_cast(float, p.y << 16), v0[3] + __builtin_bit_cast(float, p.y & 0xffff0000u));
                    w.z = cvt_pk_bf16(v1[0] + __builtin_bit_cast(float, p.z << 16), v1[1] + __builtin_bit_cast(float, p.z & 0xffff0000u));
                    w.w = cvt_pk_bf16(v1[2] + __builtin_bit_cast(float, p.w << 16), v1[3] + __builtin_bit_cast(float, p.w & 0xffff0000u));
                    *(u32x4*)(O + off + bj * HALF) = w; } }
    }
};
}
constexpr int DM = 2048, NBATCH = 2, SEQ = 8192, NMETA = 16;
constexpr int MX = NBATCH * SEQ;
constexpr int MROWS = MX + NMETA;
constexpr int MP = 16640;
constexpr int LSEQ = SEQ + NMETA;
constexpr int NCH = 129;
constexpr int NHEAD = 16;
constexpr int IN_COLS = 6592, IN_PAD = 6656, ZC_LD = 3072, ZR_LD = 3584;
constexpr int DFF = 5632;
constexpr int NITEM = NBATCH * NCH * NHEAD;
constexpr float RMS_EPS = 1e-6f, GN_EPS = 64e-5f, DECAY_SCALE = 0.60653065971263342f;
constexpr int NWAVES = 8, NTHR = 512;
constexpr int KSPLIT = 768;
constexpr int LDS_BYTES = 147456;
constexpr size_t MiB = 1u << 20;
constexpr size_t WS_BAR = 65536;
constexpr size_t WS_WIN = 1 * MiB, WS_WOUT = 27 * MiB, WS_WLORA = 35 * MiB, WS_BUFA = 38 * MiB;
constexpr size_t WS_ZR = 103 * MiB, WS_LODA = 217 * MiB, WS_LOG = 282 * MiB, WS_ZC = 315 * MiB, WS_LA = 413 * MiB;
constexpr size_t WS_LA1 = WS_LA, WS_LA2 = WS_LA + (size_t)MP * 256 * 2, WS_WL1 = WS_WLORA, WS_WL2 = WS_WLORA + (size_t)2048 * 256 * 2;
constexpr size_t WS_MF = 315 * MiB, C1ARR = (size_t)NITEM * 8192, WS_QF = WS_MF + C1ARR, WS_NB = WS_QF + C1ARR, WS_Y1 = WS_NB + C1ARR;
constexpr size_t WS_HST = 444 * MiB, WS_BON = 476 * MiB + 512 * 1024;
constexpr size_t WS_WGU = 217 * MiB, WS_WDN = 478 * MiB;
constexpr size_t WS_MIX = 103 * MiB, WS_ACT = 262 * MiB, WS_G4 = 438 * MiB, WS_U2 = 460 * MiB, WS_F = 167 * MiB;
constexpr size_t WS_MIXM = 501 * MiB, WS_N2M = 501 * MiB + 256 * 1024, WS_GM = 501 * MiB + 512 * 1024, WS_END = 502 * MiB;
static_assert(WS_Y1 + C1ARR <= WS_HST && WS_HST + C1ARR <= WS_BON && WS_BON + (size_t)NBATCH * NCH * 64 * NHEAD * 4 <= WS_WDN, "ws map");

typedef unsigned short bf16;
typedef unsigned v4u __attribute__((ext_vector_type(4)));
typedef unsigned v2u __attribute__((ext_vector_type(2)));
typedef float f32x4 __attribute__((ext_vector_type(4)));
typedef short bf16x8 __attribute__((ext_vector_type(8)));
#define LDS_WAIT() asm volatile("s_waitcnt lgkmcnt(0)" ::: "memory")
#define DI __device__ __forceinline__
typedef float f32x2_t __attribute__((ext_vector_type(2)));
typedef __bf16 bf16x2_t __attribute__((ext_vector_type(2)));
DI unsigned pk2(float lo, float hi) { const f32x2_t v = {lo, hi}; const bf16x2_t r = __builtin_convertvector(v, bf16x2_t); return __builtin_bit_cast(unsigned, r); }
DI unsigned f2bf(float f) { return pk2(f, 0.f) & 0xffffu; }
DI float bflo(unsigned w) { return __builtin_bit_cast(float, w << 16); }
DI float bfhi(unsigned w) { return __builtin_bit_cast(float, w & 0xffff0000u); }
DI float bf2f(bf16 b) { return __builtin_bit_cast(float, ((unsigned)b) << 16); }
DI void unpack8(const v4u w, float (&o)[8]) { o[0] = bflo(w.x); o[1] = bfhi(w.x); o[2] = bflo(w.y); o[3] = bfhi(w.y); o[4] = bflo(w.z); o[5] = bfhi(w.z); o[6] = bflo(w.w); o[7] = bfhi(w.w); }
DI v4u pack8(const float (&o)[8]) { v4u w; w.x = pk2(o[0], o[1]); w.y = pk2(o[2], o[3]); w.z = pk2(o[4], o[5]); w.w = pk2(o[6], o[7]); return w; }
DI float sigmoidf_(float x) { return __builtin_amdgcn_rcpf(1.0f + __expf(-x)); }
DI float wave_sum(float v) {
#pragma unroll
    for (int o = 1; o < 64; o <<= 1) v += __shfl_xor(v, o);
    return v;
}
DI int prev_row(int t) { if (t >= MX) return t == MX ? -1 : t - 1; return (t % SEQ == 0) ? (MX + NMETA - 1) : t - 1; }

struct Args { const float* in[23]; float* out; unsigned char* ws; };

DI void tr_item(const float* W, int N, bf16* WT, int Kd, int k0, int n0, int drow0, float* scr, int lane) {
    float tv[64];
#pragma unroll
    for (int i = 0; i < 64; ++i) tv[i] = W[(size_t)(k0 + i) * N + n0 + lane];
#pragma unroll
    for (int i = 0; i < 64; ++i) scr[i * 65 + lane] = tv[i];
    LDS_WAIT();
    const int c = lane & 7;
#pragma unroll
    for (int j = 0; j < 8; ++j) { const int n = (lane >> 3) + 8 * j; const float* s = scr + (8 * c) * 65 + n;
        v4u o; o.x = pk2(s[0 * 65], s[1 * 65]); o.y = pk2(s[2 * 65], s[3 * 65]); o.z = pk2(s[4 * 65], s[5 * 65]); o.w = pk2(s[6 * 65], s[7 * 65]);
        *(v4u*)(WT + (size_t)(drow0 + n) * Kd + k0 + 8 * c) = o; }
    LDS_WAIT();
}
DI void rms_row_bf16(const float* src, const float* gain, bf16* dst, int lane) {
    v2u* o8 = (v2u*)dst + lane;
    if (!src) {
#pragma unroll
        for (int j = 0; j < 8; ++j) o8[64 * j] = (v2u){0u, 0u};
        return; }
    const f32x4* xr = (const f32x4*)src + lane; const f32x4* gr = (const f32x4*)gain + lane;
    f32x4 v[8], g[8]; float s = 0.f;
#pragma unroll
    for (int j = 0; j < 8; ++j) { v[j] = xr[64 * j]; g[j] = gr[64 * j]; }
#pragma unroll
    for (int j = 0; j < 8; ++j) s += (v[j].x * v[j].x + v[j].y * v[j].y) + (v[j].z * v[j].z + v[j].w * v[j].w);
    const float rs = 1.0f / sqrtf(wave_sum(s) * (1.0f / DM) + RMS_EPS);
#pragma unroll
    for (int j = 0; j < 8; ++j) o8[64 * j] = (v2u){pk2(v[j].x * rs * g[j].x, v[j].y * rs * g[j].y), pk2(v[j].z * rs * g[j].z, v[j].w * rs * g[j].w)};
}
template <int NC>
DI void gemv2_rows(const bf16* a0, const bf16* a1, const bf16* const (&brow)[NC], int lane, float (&o0)[NC], float (&o1)[NC]) {
    v4u xa[4], xb[4], w[NC][4];
#pragma unroll
    for (int i = 0; i < 4; ++i) { xa[i] = *(const v4u*)(a0 + lane * 8 + 512 * i); xb[i] = *(const v4u*)(a1 + lane * 8 + 512 * i); }
#pragma unroll
    for (int c = 0; c < NC; ++c)
#pragma unroll
        for (int i = 0; i < 4; ++i) w[c][i] = *(const v4u*)(brow[c] + lane * 8 + 512 * i);
#pragma unroll
    for (int c = 0; c < NC; ++c) {
        float s0 = 0.f, s1 = 0.f;
#pragma unroll
        for (int i = 0; i < 4; ++i) { float x0[8], x1[8], ww[8]; unpack8(xa[i], x0); unpack8(xb[i], x1); unpack8(w[c][i], ww);
#pragma unroll
            for (int e = 0; e < 8; ++e) { s0 += x0[e] * ww[e]; s1 += x1[e] * ww[e]; } }
        o0[c] = wave_sum(s0); o1[c] = wave_sum(s1);
    }
}
#define XB_TMO      128
#define XB_XCNT(j)  (256  + 64 * (j))
#define XB_XSUB(j)  (1280 + 64 * (j))
#define XB_XGEN(j)  (2304 + 64 * (j))
#define XB_TOP      3328
#define XB_TOPGEN   3392
#define XCD_BAR_WORDS 3456
#define XB_SPIN_CAP (1u << 18)

__device__ __forceinline__ unsigned xb_ld(unsigned* p)              { return __hip_atomic_load(p, __ATOMIC_RELAXED, __HIP_MEMORY_SCOPE_AGENT); }
__device__ __forceinline__ unsigned xb_add(unsigned* p, unsigned v) { return __hip_atomic_fetch_add(p, v, __ATOMIC_RELAXED, __HIP_MEMORY_SCOPE_AGENT); }
__device__ __forceinline__ unsigned xb_xcc_id() { return (unsigned)__builtin_amdgcn_s_getreg((3 << 11) | 20) & 0xFu; }
#define XB_SPIN(cond, bar) do { unsigned _sp = 0; while (cond) { __builtin_amdgcn_s_sleep(1); \
    if ((++_sp & 255u) == 0u) { if (xb_ld(&(bar)[XB_TMO])) break; if (_sp > XB_SPIN_CAP) { atomicAdd(&(bar)[XB_TMO], 1u); break; } } } } while (0)

struct XcdBarrier {
    unsigned* bar; unsigned x;
    volatile __attribute__((address_space(3))) unsigned* st;
};

__device__ __forceinline__ XcdBarrier xcd_barrier_post(unsigned* bar, volatile __attribute__((address_space(3))) unsigned* st) {
    XcdBarrier b; b.bar = bar; b.x = xb_xcc_id(); b.st = st;
    if (threadIdx.x == 0) (void)xb_add(&bar[XB_XCNT(b.x)], 1u);
    return b;
}
__device__ __forceinline__ void xcd_barrier_complete(unsigned* bar, unsigned x, unsigned& nloc, unsigned& nx) {
    const unsigned G = gridDim.x * gridDim.y * gridDim.z;
    unsigned sum, cnt, mine, sp = 0u;
    for (;;) {
        sum = 0u; cnt = 0u; mine = 0u;
#pragma unroll
        for (unsigned j = 0; j < 16; ++j) { const unsigned c = xb_ld(&bar[XB_XCNT(j)]); sum += c; cnt += (c > 0u) ? 1u : 0u; mine = (j == x) ? c : mine; }
        if (sum == G) break;
        __builtin_amdgcn_s_sleep(1);
        if ((++sp & 255u) == 0u) { if (xb_ld(&bar[XB_TMO])) break; if (sp > XB_SPIN_CAP) { atomicAdd(&bar[XB_TMO], 1u); break; } }
    }
    nloc = mine > 0u ? mine : 1u; nx = cnt > 0u ? cnt : 1u;
}

__device__ __forceinline__ void xcd_barrier(const XcdBarrier& b) {
    asm volatile("s_waitcnt vmcnt(0)" ::: "memory");
    __syncthreads();
    if (threadIdx.x == 0) {
        unsigned* bar = b.bar;
        __builtin_amdgcn_s_waitcnt(0);
        unsigned nloc = b.st[0], nx = b.st[1];
        if (nloc == 0u) { xcd_barrier_complete(bar, b.x, nloc, nx); b.st[0] = nloc; b.st[1] = nx; }
        const unsigned old = xb_add(&bar[XB_XSUB(b.x)], 1u);
        const unsigned gen = old / nloc;
        if (old + 1u == (gen + 1u) * nloc) {
            __builtin_amdgcn_fence(__ATOMIC_RELEASE, "agent");
            asm volatile("s_waitcnt vmcnt(0)" ::: "memory");
            const unsigned og = xb_add(&bar[XB_TOP], 1u);
            const unsigned tg = og / nx;
            if (og + 1u == (tg + 1u) * nx) xb_add(&bar[XB_TOPGEN], 1u);
            else XB_SPIN(xb_ld(&bar[XB_TOPGEN]) == tg, bar);
            __builtin_amdgcn_fence(__ATOMIC_ACQUIRE, "agent");
            xb_add(&bar[XB_XGEN(b.x)], 1u);
            asm volatile("s_waitcnt vmcnt(0)" ::: "memory");
        } else {
            XB_SPIN(xb_ld(&bar[XB_XGEN(b.x)]) == gen, bar);
            __builtin_amdgcn_fence(__ATOMIC_ACQUIRE, "agent");
            asm volatile("s_waitcnt vmcnt(0)" ::: "memory");
        }
    }
    __syncthreads();
}

DI void phase0(const Args& A, unsigned char* lds, int gw, int NGW, int wave, int lane) {
    unsigned char* ws = A.ws;
    float* scr = (float*)(lds + wave * 16640);
    bf16* WIN = (bf16*)(ws + WS_WIN); bf16* WOUT = (bf16*)(ws + WS_WOUT);
    constexpr int I_IN = (DM / 64) * (IN_COLS / 64), I_OUT = (DM / 64) * (DM / 64);
    for (int it = gw; it < I_IN + I_OUT; it += NGW) {
        if (it < I_IN) { const int kb = it / (IN_COLS / 64), nb = it % (IN_COLS / 64); tr_item(A.in[3], IN_COLS, WIN, DM, kb * 64, nb * 64, nb * 64, scr, lane); }
        else { const int r = it - I_IN, kb = r / (DM / 64), nb = r % (DM / 64); tr_item(A.in[16], DM, WOUT, DM, kb * 64, nb * 64, nb * 64, scr, lane); }
    }
    for (int i = gw * 64 + lane; i < (IN_PAD - IN_COLS) * DM / 8; i += NGW * 64) ((v4u*)(WIN + (size_t)IN_COLS * DM))[i] = (v4u){0u, 0u, 0u, 0u};
    { bf16* WL1 = (bf16*)(ws + WS_WL1); bf16* WL2 = (bf16*)(ws + WS_WL2);
#pragma unroll 4
      for (int i = gw * 64 + lane; i < 2048 * 256; i += NGW * 64) {
          const int n = i >> 8, k = i & 255, seg = n >> 10;
          const bool ok = seg == 0 ? (k < 96) : (k >= 128 && k < 224);
          const float* srcp = seg == 0 ? A.in[6] : A.in[8];
          const int kk = seg == 0 ? k : k - 128;
          const float v = srcp[ok ? kk * 1024 + (n & 1023) : 0];
          WL1[i] = ok ? (bf16)f2bf(v) : (bf16)0;
      }
#pragma unroll 4
      for (int i = gw * 64 + lane; i < 1024 * 256; i += NGW * 64) { const int n = i >> 8, k = i & 255; WL2[i] = (bf16)f2bf(A.in[10][k * 1024 + n]); }
    }
    bf16* XN = (bf16*)(ws + WS_BUFA);
    for (int m = gw; m < MP; m += NGW) {
        const float* src = m < MX ? A.in[0] + (size_t)m * DM : (m < MROWS ? A.in[1] + (size_t)(m - MX) * DM : nullptr);
        rms_row_bf16(src, A.in[2], XN + (size_t)m * DM, lane);
    }
}
DI void convert_late(const Args& A, unsigned char* lds, int cw, int NCW, int wave, int lane) {
    unsigned char* ws = A.ws; float* scr = (float*)(lds + wave * 16640);
    bf16* WGU = (bf16*)(ws + WS_WGU); bf16* WDN = (bf16*)(ws + WS_WDN);
    constexpr int I_GU = (DM / 64) * (2 * DFF / 64), I_DN = (DFF / 64) * (DM / 64);
    for (int it = cw; it < I_GU + I_DN; it += NCW) {
        if (it < I_GU) { const int kb = it / (2 * DFF / 64), nb = it % (2 * DFF / 64); const int n0 = nb * 64; const int j = n0 < DFF ? n0 : n0 - DFF;
            const int drow = 256 * (j >> 7) + (n0 < DFF ? 0 : 128) + (j & 127);
            tr_item(A.in[19], 2 * DFF, WGU, DM, kb * 64, n0, drow, scr, lane); }
        else { const int r = it - I_GU, kb = r / (DM / 64), nb = r % (DM / 64); tr_item(A.in[21], DM, WDN, DFF, kb * 64, nb * 64, nb * 64, scr, lane); }
    }
}
DI void phase2a(const Args& A, int gw, int NGW, int lane) {
    unsigned char* ws = A.ws;
    const bf16* ZC = (const bf16*)(ws + WS_ZC); const bf16* ZR = (const bf16*)(ws + WS_ZR); bf16* YA = (bf16*)(ws + WS_BUFA); bf16* LA = (bf16*)(ws + WS_LA);
    const float* cwp = A.in[4]; const float* mu = A.in[5];
    float w0[16], w1[16], w2[16];
#pragma unroll
    for (int e4 = 0; e4 < 4; ++e4) { const f32x4 a = *(const f32x4*)(cwp + lane * 16 + 4 * e4), b = *(const f32x4*)(cwp + 1024 + lane * 16 + 4 * e4), c = *(const f32x4*)(cwp + 2048 + lane * 16 + 4 * e4);
#pragma unroll
        for (int x = 0; x < 4; ++x) { w0[4 * e4 + x] = a[x]; w1[4 * e4 + x] = b[x]; w2[4 * e4 + x] = c[x]; } }
    int src = 0, kind = 0;
    if (lane < 12) { src = 3072 + 8 * lane; kind = 1; } else if (lane >= 16 && lane < 28) { src = 3168 + 8 * (lane - 16); kind = 2; } else if (lane >= 32) { src = 3264 + 8 * (lane - 32); kind = 3; }
    float mus[8];
    { const f32x4 a = *(const f32x4*)(mu + src), b = *(const f32x4*)(mu + src + 4); mus[0] = a.x; mus[1] = a.y; mus[2] = a.z; mus[3] = a.w; mus[4] = b.x; mus[5] = b.y; mus[6] = b.z; mus[7] = b.w; }
    for (int t = gw; t < MROWS; t += NGW) {
        const int t1 = prev_row(t), t2 = t1 >= 0 ? prev_row(t1) : -1;
        const int r1 = t1 >= 0 ? t1 : t, r2 = t2 >= 0 ? t2 : t;
        const float f1 = t1 >= 0 ? 1.f : 0.f, f2 = t2 >= 0 ? 1.f : 0.f;
        v4u lb[2], lc0[2], lh0[2], lc1[2], lh1[2], lc2[2], lh2[2];
#pragma unroll
        for (int hv = 0; hv < 2; ++hv) {
            const int c8 = lane * 16 + hv * 8;
            const bf16* z0 = ZC + (size_t)t * ZC_LD + c8; const bf16* z1 = ZC + (size_t)r1 * ZC_LD + c8; const bf16* z2 = ZC + (size_t)r2 * ZC_LD + c8;
            lb[hv] = *(const v4u*)z0; lc0[hv] = *(const v4u*)(z0 + 1024); lh0[hv] = *(const v4u*)(z0 + 2048);
            lc1[hv] = *(const v4u*)(z1 + 1024); lh1[hv] = *(const v4u*)(z1 + 2048); lc2[hv] = *(const v4u*)(z2 + 1024); lh2[hv] = *(const v4u*)(z2 + 2048);
        }
        const v4u lz = *(const v4u*)(ZR + (size_t)t * ZR_LD + src), lzp = *(const v4u*)(ZR + (size_t)r1 * ZR_LD + src);
#pragma unroll
        for (int hv = 0; hv < 2; ++hv) {
            const int c8 = lane * 16 + hv * 8;
            float bv[8], c0[8], h0[8], c1[8], h1[8], c2[8], h2[8], o[8];
            unpack8(lb[hv], bv); unpack8(lc0[hv], c0); unpack8(lh0[hv], h0); unpack8(lc1[hv], c1); unpack8(lh1[hv], h1); unpack8(lc2[hv], c2); unpack8(lh2[hv], h2);
#pragma unroll
            for (int e = 0; e < 8; ++e) o[e] = bv[e] * (w0[hv * 8 + e] * (f2 * c2[e] * h2[e]) + w1[hv * 8 + e] * (f1 * c1[e] * h1[e]) + w2[hv * 8 + e] * (c0[e] * h0[e]));
            *(v4u*)(YA + (size_t)t * DM + c8) = pack8(o);
        }
        v4u outw = (v4u){0u, 0u, 0u, 0u};
        if (kind != 0) {
            float z[8], zp[8], o[8]; unpack8(lz, z); unpack8(lzp, zp);
#pragma unroll
            for (int e = 0; e < 8; ++e) { const float s = z[e] + (f1 * zp[e] - z[e]) * mus[e];
                const float th = 1.0f - 2.0f * __builtin_amdgcn_rcpf(1.0f + __expf(2.0f * s));
                o[e] = kind == 1 ? th : (kind == 2 ? s : sigmoidf_(s)); }
            outw = pack8(o);
        }
        *(v4u*)(lane < 32 ? LA + (size_t)t * 256 + 8 * lane : LA + (size_t)MP * 256 + (size_t)t * 256 + 8 * (lane - 32)) = outw;
    }
}
constexpr int LP = 144;
constexpr int L_AT = 0, L_BT = 9216, L_KT = 18432, L_RT = 27648, L_BHT = 36864, L_KHT = 46080, L_VT = 55296, L_AAK = 64512, L_ARB = 73728, L_ARK = 82944, L_AAB = 92160;
constexpr int L_WT = 101376;
constexpr int L_GC = 103424;
constexpr int L_TD = 103680;
constexpr int L_PAR = 105728;
constexpr int L_XT = L_BT;
constexpr int L_SQ = L_AT, L_SM = L_BT, L_SN = L_KT, L_SY = L_RT;
static_assert(L_PAR + 2048 <= 131072, "lds");
#define MFMA16(a, b, c) __builtin_amdgcn_mfma_f32_16x16x32_bf16((a), (b), (c), 0, 0, 0)
DI bf16x8 ldfrag(const unsigned char* base, int row, int s, int q) { return *(const bf16x8*)(base + row * LP + (s * 32 + q * 8) * 2); }
DI bf16x8 ldfrag_sw(const unsigned char* base, int row, int s, int q) { return *(const bf16x8*)(base + row * LP + (((s * 4 + q) ^ ((row >> 3) & 7)) * 16)); }
DI void st_bf(unsigned char* base, int row, int col, float v) { *(bf16*)(base + row * LP + col * 2) = (bf16)f2bf(v); }
DI bf16x8 half_frag(v2u lo) { v4u w; w.x = lo.x; w.y = lo.y; w.z = 0u; w.w = 0u; return __builtin_bit_cast(bf16x8, w); }

struct C1Raw { v4u z[3], zp[3], dec, aa; };
DI void c1_rows(int b, int c, int i, int& pos, bool& valid, int& row, int& prow) {
    pos = c * 64 + i; valid = pos < LSEQ;
    row = valid ? (pos < NMETA ? MX + pos : b * SEQ + pos - NMETA) : 0; prow = prev_row(row);
}
DI void c1_load(C1Raw& R, const bf16* ZR, const bf16* LODA, int b, int c, int i, int col) {
    int pos, row, prow; bool valid; c1_rows(b, c, i, pos, valid, row, prow);
    const bf16* zr = ZR + (size_t)row * ZR_LD + col; const bf16* zpr = ZR + (size_t)(prow >= 0 ? prow : 0) * ZR_LD + col;
#pragma unroll
    for (int p = 0; p < 3; ++p) { R.z[p] = *(const v4u*)(zr + p * 1024); R.zp[p] = *(const v4u*)(zpr + p * 1024); }
    R.dec = *(const v4u*)(LODA + (size_t)row * 2048 + col); R.aa = *(const v4u*)(LODA + (size_t)row * 2048 + 1024 + col);
}

DI void phase_c1(const Args& A, unsigned char* lds_, int bx, int G, int tid, int wave, int lane) {
    unsigned char* ws = A.ws;
    const bf16* ZR = (const bf16*)(ws + WS_ZR); const bf16* LODA = (const bf16*)(ws + WS_LODA);
    float* BON = (float*)(ws + WS_BON);
    const int r16 = lane & 15, q = lane >> 4;
    const int tm = wave >> 1, tn0 = (wave & 1) * 2;
    const int h = bx & 15, NBC = NBATCH * NCH, bc0 = bx >> 4, bcs = G >> 4;
    const int i = tid >> 3, cgp = tid & 7, c0 = cgp * 8, col = h * 64 + c0;
    { float* PAR = (float*)(lds_ + L_PAR); const int pa = tid >> 6, ch = tid & 63; const float* src = pa < 3 ? A.in[5] + pa * 1024 : (pa == 3 ? A.in[7] : pa == 4 ? A.in[9] : pa == 5 ? A.in[11] : pa == 6 ? A.in[12] : A.in[13]);
      PAR[pa * 64 + ch] = src[h * 64 + ch]; }
    __syncthreads();
    if (bc0 >= NBC) return;
    C1Raw cur; c1_load(cur, ZR, LODA, bc0 / NCH, bc0 % NCH, i, col);
    for (int bc = bc0; bc < NBC; bc += bcs) {
        int oz = 0; asm volatile("" : "+s"(oz));
        unsigned char* L = lds_ + oz; float* WT = (float*)(L + L_WT); float* GC = (float*)(L + L_GC); const float* PAR = (const float*)(L + L_PAR);
        const int c = bc % NCH, b = bc / NCH, item = (b * 16 + h) * NCH + c;
        int pos, row, prow; bool valid; c1_rows(b, c, i, pos, valid, row, prow);
        float rr[8], vr[8], lw[8], av[8], bv[8], kp[8];
        {
            float mur[8], muk[8], muv[8], w0v[8], a0v[8], kkv[8], kav[8], rkv[8];
#pragma unroll
            for (int e = 0; e < 8; ++e) { mur[e] = PAR[c0 + e]; muk[e] = PAR[64 + c0 + e]; muv[e] = PAR[128 + c0 + e]; w0v[e] = PAR[192 + c0 + e]; a0v[e] = PAR[256 + c0 + e];
                kkv[e] = PAR[320 + c0 + e]; kav[e] = PAR[384 + c0 + e]; rkv[e] = PAR[448 + c0 + e]; }
            float kr[8], z[8], zp[8];
            unpack8(cur.z[0], z); unpack8(cur.zp[0], zp);
#pragma unroll
            for (int e = 0; e < 8; ++e) { const float zq = prow >= 0 ? zp[e] : 0.f; rr[e] = z[e] + (zq - z[e]) * mur[e]; }
            unpack8(cur.z[1], z); unpack8(cur.zp[1], zp);
#pragma unroll
            for (int e = 0; e < 8; ++e) { const float zq = prow >= 0 ? zp[e] : 0.f; kr[e] = z[e] + (zq - z[e]) * muk[e]; }
            unpack8(cur.z[2], z); unpack8(cur.zp[2], zp);
#pragma unroll
            for (int e = 0; e < 8; ++e) { const float zq = prow >= 0 ? zp[e] : 0.f; vr[e] = z[e] + (zq - z[e]) * muv[e]; }
            float dec[8], aa[8]; unpack8(cur.dec, dec); unpack8(cur.aa, aa);
            { const int bn = bc + bcs; if (bn < NBC) c1_load(cur, ZR, LODA, bn / NCH, bn % NCH, i, col); }
            float ss = 0.f, bon = 0.f, as[8], kk[8];
#pragma unroll
            for (int e = 0; e < 8; ++e) {
                lw[e] = -DECAY_SCALE * sigmoidf_(w0v[e] + dec[e]);
                as[e] = sigmoidf_(a0v[e] + aa[e]);
                kk[e] = kr[e] * kkv[e]; ss += kk[e] * kk[e];
                kp[e] = kr[e] * (1.0f + (as[e] - 1.0f) * kav[e]);
                bon += rr[e] * kp[e] * rkv[e];
            }
            ss += __shfl_xor(ss, 1); ss += __shfl_xor(ss, 2); ss += __shfl_xor(ss, 4);
            bon += __shfl_xor(bon, 1); bon += __shfl_xor(bon, 2); bon += __shfl_xor(bon, 4);
            const float inv = __builtin_amdgcn_rcpf(fmaxf(__builtin_amdgcn_sqrtf(ss), 1e-12f));
#pragma unroll
            for (int e = 0; e < 8; ++e) { const float kn = kk[e] * inv; av[e] = -kn; bv[e] = kn * as[e]; }
            if (!valid) {
#pragma unroll
                for (int e = 0; e < 8; ++e) { lw[e] = 0.f; rr[e] = 0.f; kp[e] = 0.f; vr[e] = 0.f; av[e] = 0.f; bv[e] = 0.f; } }
            if (cgp == 0 && valid) BON[((size_t)b * (NCH * 64) + pos) * NHEAD + h] = bon;
        }
        float Lc[8];
#pragma unroll
        for (int e = 0; e < 8; ++e) { float v = lw[e];
            float t = __shfl_up(v, 8); if (lane >= 8) v += t;
            t = __shfl_up(v, 16); if (lane >= 16) v += t;
            t = __shfl_up(v, 32); if (lane >= 32) v += t;
            Lc[e] = v; }
        if (lane >= 56) { *(f32x4*)(WT + wave * 64 + c0) = (f32x4){Lc[0], Lc[1], Lc[2], Lc[3]}; *(f32x4*)(WT + wave * 64 + c0 + 4) = (f32x4){Lc[4], Lc[5], Lc[6], Lc[7]}; }
        __syncthreads();
        {
            float pre[8], tot[8];
#pragma unroll
            for (int e = 0; e < 8; ++e) { pre[e] = 0.f; tot[e] = 0.f; }
#pragma unroll
            for (int g = 0; g < 8; ++g) { const f32x4 t0 = *(const f32x4*)(WT + g * 64 + c0), t1 = *(const f32x4*)(WT + g * 64 + c0 + 4);
                const float tv[8] = {t0.x, t0.y, t0.z, t0.w, t1.x, t1.y, t1.z, t1.w};
#pragma unroll
                for (int e = 0; e < 8; ++e) { tot[e] += tv[e]; if (g < wave) pre[e] += tv[e]; } }
            float at[8], rt[8], bt[8], kt[8];
            const int swb = ((wave ^ cgp) * 16) + (i & 7) * 2;
#pragma unroll
            for (int e = 0; e < 8; ++e) {
                const float Lv = Lc[e] + pre[e], Lt = tot[e];
                const float eL = __expf(Lv), eLex = __expf(Lv - lw[e]), einv = __expf(-Lv), eh = __expf(Lt - Lv);
                at[e] = av[e] * eLex; rt[e] = rr[e] * eL; bt[e] = bv[e] * einv; kt[e] = kp[e] * einv;
                *(bf16*)(L + L_BHT + (c0 + e) * LP + swb) = (bf16)f2bf(bv[e] * eh);
                *(bf16*)(L + L_KHT + (c0 + e) * LP + swb) = (bf16)f2bf(kp[e] * eh);
                *(bf16*)(L + L_VT + (c0 + e) * LP + swb) = (bf16)f2bf(vr[e]);
                if (i == 63) GC[c0 + e] = eL;
            }
            *(v4u*)(L + L_AT + i * LP + c0 * 2) = pack8(at); *(v4u*)(L + L_RT + i * LP + c0 * 2) = pack8(rt);
            *(v4u*)(L + L_BT + i * LP + c0 * 2) = pack8(bt); *(v4u*)(L + L_KT + i * LP + c0 * 2) = pack8(kt);
        }
        __syncthreads();
        {
            f32x4 aab[2], aak[2], arb[2], ark[2];
#pragma unroll
            for (int t = 0; t < 2; ++t) { aab[t] = (f32x4){0.f, 0.f, 0.f, 0.f}; aak[t] = aab[t]; arb[t] = aab[t]; ark[t] = aab[t]; }
#pragma unroll
            for (int s = 0; s < 2; ++s) {
                const bf16x8 fa = ldfrag(L + L_AT, tm * 16 + r16, s, q), fr_ = ldfrag(L + L_RT, tm * 16 + r16, s, q);
#pragma unroll
                for (int t = 0; t < 2; ++t) {
                    const bf16x8 fb = ldfrag(L + L_BT, (tn0 + t) * 16 + r16, s, q), fk = ldfrag(L + L_KT, (tn0 + t) * 16 + r16, s, q);
                    aab[t] = MFMA16(fa, fb, aab[t]); aak[t] = MFMA16(fa, fk, aak[t]); arb[t] = MFMA16(fr_, fb, arb[t]); ark[t] = MFMA16(fr_, fk, ark[t]);
                }
            }
#pragma unroll
            for (int t = 0; t < 2; ++t)
#pragma unroll
                for (int jj = 0; jj < 4; ++jj) {
                    const int ri = tm * 16 + 4 * q + jj, cj = (tn0 + t) * 16 + r16;
                    st_bf(L + L_AAB, ri, cj, cj < ri ? aab[t][jj] : 0.f);
                    st_bf(L + L_AAK, ri, cj, cj < ri ? aak[t][jj] : 0.f);
                    st_bf(L + L_ARB, ri, cj, cj <= ri ? arb[t][jj] : 0.f);
                    st_bf(L + L_ARK, ri, cj, cj <= ri ? ark[t][jj] : 0.f);
                }
        }
        __syncthreads();
        if (wave == 0) {
            const int db = lane >> 4, dj = lane & 15; float x[16];
#pragma unroll
            for (int hf = 0; hf < 2; ++hf) {
                v4u ra[8][2];
#pragma unroll
                for (int r8 = 0; r8 < 8; ++r8) { const int r = hf * 8 + r8;
                    ra[r8][0] = *(const v4u*)(L + L_AAB + (16 * db + r) * LP + (16 * db) * 2); ra[r8][1] = *(const v4u*)(L + L_AAB + (16 * db + r) * LP + (16 * db + 8) * 2); }
#pragma unroll
                for (int r8 = 0; r8 < 8; ++r8) { const int r = hf * 8 + r8;
                    float a[16]; float t0[8], t1[8]; unpack8(ra[r8][0], t0); unpack8(ra[r8][1], t1);
#pragma unroll
                    for (int e = 0; e < 8; ++e) { a[e] = t0[e]; a[8 + e] = t1[e]; }
                    float acc = (r == dj) ? 1.0f : 0.f;
#pragma unroll
                    for (int k = 0; k < 16; ++k) if (k < r) acc = fmaf(a[k], x[k], acc);
                    x[r] = acc; }
                asm volatile("" ::: "memory");
            }
#pragma unroll
            for (int r = 0; r < 16; ++r) *(bf16*)(L + L_TD + db * 512 + r * 32 + dj * 2) = (bf16)f2bf(x[r]);
        }
        f32x4 y1a[2], nna[2], Rs[4];
        {
#pragma unroll
            for (int t = 0; t < 2; ++t) { y1a[t] = (f32x4){0.f, 0.f, 0.f, 0.f}; nna[t] = y1a[t]; }
#pragma unroll
            for (int s = 0; s < 2; ++s) {
                const bf16x8 frk = ldfrag(L + L_ARK, tm * 16 + r16, s, q), fkh = ldfrag_sw(L + L_KHT, tm * 16 + r16, s, q);
#pragma unroll
                for (int t = 0; t < 2; ++t) {
                    const bf16x8 fv = ldfrag_sw(L + L_VT, (tn0 + t) * 16 + r16, s, q);
                    y1a[t] = MFMA16(frk, fv, y1a[t]); nna[t] = MFMA16(fkh, fv, nna[t]);
                }
            }
            if (wave < 4) {
#pragma unroll
                for (int bb = 0; bb < 4; ++bb)
#pragma unroll
                    for (int jj = 0; jj < 4; ++jj) Rs[bb][jj] = bf2f(*(const bf16*)(L + L_AT + (16 * bb + 4 * q + jj) * LP + (16 * wave + r16) * 2));
            } else {
#pragma unroll
                for (int bb = 0; bb < 4; ++bb) Rs[bb] = (f32x4){0.f, 0.f, 0.f, 0.f};
#pragma unroll
                for (int s = 0; s < 2; ++s) {
                    const bf16x8 fv = ldfrag_sw(L + L_VT, (wave - 4) * 16 + r16, s, q);
#pragma unroll
                    for (int bb = 0; bb < 4; ++bb) Rs[bb] = MFMA16(ldfrag(L + L_AAK, 16 * bb + r16, s, q), fv, Rs[bb]);
                }
            }
        }
        __syncthreads();
        {
            bf16x8 xb[4];
#pragma unroll
            for (int bb = 0; bb < 4; ++bb) {
                f32x4 acc = Rs[bb];
#pragma unroll
                for (int bp = 0; bp < 4; ++bp) if (bp < bb) acc = MFMA16(half_frag(*(const v2u*)(L + L_AAB + (16 * bb + r16) * LP + (16 * bp + 4 * q) * 2)), xb[bp], acc);
                v2u pb; pb.x = pk2(acc[0], acc[1]); pb.y = pk2(acc[2], acc[3]);
                const f32x4 xa = MFMA16(half_frag(*(const v2u*)(L + L_TD + bb * 512 + r16 * 32 + 4 * q * 2)), half_frag(pb), ((f32x4){0.f, 0.f, 0.f, 0.f}));
                v2u px; px.x = pk2(xa[0], xa[1]); px.y = pk2(xa[2], xa[3]);
                xb[bb] = half_frag(px);
                *(v2u*)(L + L_XT + (16 * wave + r16) * LP + (16 * bb + 4 * q) * 2) = px;
            }
        }
        __syncthreads();
        f32x4 qa[2], ma[2];
        {
#pragma unroll
            for (int t = 0; t < 2; ++t) { qa[t] = (f32x4){0.f, 0.f, 0.f, 0.f}; ma[t] = qa[t]; }
#pragma unroll
            for (int s = 0; s < 2; ++s) {
                const bf16x8 frb = ldfrag(L + L_ARB, tm * 16 + r16, s, q), fbh = ldfrag_sw(L + L_BHT, tm * 16 + r16, s, q);
#pragma unroll
                for (int t = 0; t < 2; ++t) {
                    const bf16x8 fw = ldfrag(L + L_XT, (tn0 + t) * 16 + r16, s, q), fu = ldfrag(L + L_XT, 64 + (tn0 + t) * 16 + r16, s, q);
                    qa[t] = MFMA16(frb, fw, qa[t]); y1a[t] = MFMA16(frb, fu, y1a[t]); ma[t] = MFMA16(fbh, fw, ma[t]); nna[t] = MFMA16(fbh, fu, nna[t]);
                }
            }
#pragma unroll
            for (int t = 0; t < 2; ++t)
#pragma unroll
                for (int jj = 0; jj < 4; ++jj) {
                    const int ri = tm * 16 + 4 * q + jj, cj = (tn0 + t) * 16 + r16;
                    qa[t][jj] += bf2f(*(const bf16*)(L + L_RT + ri * LP + cj * 2));
                    if (ri == cj) ma[t][jj] += GC[ri];
                }
        }
        __syncthreads();
#pragma unroll
        for (int t = 0; t < 2; ++t)
#pragma unroll
            for (int jj = 0; jj < 4; ++jj) {
                const int ri = tm * 16 + 4 * q + jj, cj = (tn0 + t) * 16 + r16;
                st_bf(L + L_SQ, ri, cj, qa[t][jj]); st_bf(L + L_SM, ri, cj, ma[t][jj]); st_bf(L + L_SN, ri, cj, nna[t][jj]); st_bf(L + L_SY, ri, cj, y1a[t][jj]);
            }
        __syncthreads();
        {
            const int fi = tid >> 6, mt = fi >> 1, s = fi & 1; const int srow = 16 * mt + r16;
            const v2u q0 = *(const v2u*)(L + L_SQ + srow * LP + (32 * s + 4 * q) * 2), q1 = *(const v2u*)(L + L_SQ + srow * LP + (32 * s + 16 + 4 * q) * 2);
            const v2u m0 = *(const v2u*)(L + L_SM + srow * LP + (32 * s + 4 * q) * 2), m1 = *(const v2u*)(L + L_SM + srow * LP + (32 * s + 16 + 4 * q) * 2);
            *(v4u*)(ws + WS_QF + (size_t)item * 8192 + tid * 16) = (v4u){q0.x, q0.y, q1.x, q1.y};
            *(v4u*)(ws + WS_MF + (size_t)item * 8192 + tid * 16) = (v4u){m0.x, m0.y, m1.x, m1.y};
            const int g4 = (tid >> 6) & 3; float o[16];
            if (tid < 256) {
#pragma unroll
                for (int m2 = 0; m2 < 4; ++m2)
#pragma unroll
                    for (int jj = 0; jj < 4; ++jj) o[m2 * 4 + jj] = bf2f(*(const bf16*)(L + L_SN + (16 * m2 + 4 * q + jj) * LP + (16 * g4 + r16) * 2));
            } else {
#pragma unroll
                for (int v2 = 0; v2 < 4; ++v2)
#pragma unroll
                    for (int jj = 0; jj < 4; ++jj) o[v2 * 4 + jj] = bf2f(*(const bf16*)(L + L_SY + (16 * g4 + 4 * q + jj) * LP + (16 * v2 + r16) * 2));
            }
            v4u w0, w1; w0.x = pk2(o[0], o[1]); w0.y = pk2(o[2], o[3]); w0.z = pk2(o[4], o[5]); w0.w = pk2(o[6], o[7]); w1.x = pk2(o[8], o[9]); w1.y = pk2(o[10], o[11]); w1.z = pk2(o[12], o[13]); w1.w = pk2(o[14], o[15]);
            unsigned char* dst = ws + (tid < 256 ? WS_NB : WS_Y1) + (size_t)item * 8192 + (size_t)(g4 * 64 + lane) * 32;
            *(v4u*)dst = w0; *(v4u*)(dst + 16) = w1;
        }
        __syncthreads();
    }
}
struct C2Stage { v4u mf[4][2]; v4u nb0, nb1; };
DI void c2_load(C2Stage& st, const unsigned char* ws, int b, int h, int vs, int lane, int cc) {
    const int cl = cc < NCH ? cc : NCH - 1; const size_t item = (size_t)(b * 16 + h) * NCH + cl;
#pragma unroll
    for (int m = 0; m < 4; ++m)
#pragma unroll
        for (int s = 0; s < 2; ++s) st.mf[m][s] = *(const v4u*)(ws + WS_MF + item * 8192 + (size_t)((m * 2 + s) * 64 + lane) * 16);
    st.nb0 = *(const v4u*)(ws + WS_NB + item * 8192 + (size_t)(vs * 64 + lane) * 32); st.nb1 = *(const v4u*)(ws + WS_NB + item * 8192 + (size_t)(vs * 64 + lane) * 32 + 16);
}
DI void c2_step(const C2Stage& st, f32x4 (&Hs)[4], unsigned char* ws, int b, int h, int vs, int lane, int cc) {
    if (cc >= NCH) return;
    const size_t item = (size_t)(b * 16 + h) * NCH + cc;
    v4u hw[2];
#pragma unroll
    for (int s = 0; s < 2; ++s) { hw[s].x = pk2(Hs[2 * s][0], Hs[2 * s][1]); hw[s].y = pk2(Hs[2 * s][2], Hs[2 * s][3]); hw[s].z = pk2(Hs[2 * s + 1][0], Hs[2 * s + 1][1]); hw[s].w = pk2(Hs[2 * s + 1][2], Hs[2 * s + 1][3]);
        *(v4u*)(ws + WS_HST + item * 8192 + (size_t)((vs * 2 + s) * 64 + lane) * 16) = hw[s]; }
    float nf[16]; { float t0[8], t1[8]; unpack8(st.nb0, t0); unpack8(st.nb1, t1);
#pragma unroll
        for (int e = 0; e < 8; ++e) { nf[e] = t0[e]; nf[8 + e] = t1[e]; } }
#pragma unroll
    for (int m = 0; m < 4; ++m) {
        f32x4 acc = (f32x4){nf[m * 4], nf[m * 4 + 1], nf[m * 4 + 2], nf[m * 4 + 3]};
#pragma unroll
        for (int s = 0; s < 2; ++s) acc = MFMA16(__builtin_bit_cast(bf16x8, st.mf[m][s]), __builtin_bit_cast(bf16x8, hw[s]), acc);
        Hs[m] = acc;
    }
    asm volatile("" ::: "memory");
}
DI void phase_c2(const Args& A, int bh, int vs, int lane) {
    unsigned char* ws = A.ws;
    const int b = bh >> 4, h = bh & 15;
    f32x4 Hs[4];
#pragma unroll
    for (int m = 0; m < 4; ++m) Hs[m] = (f32x4){0.f, 0.f, 0.f, 0.f};
    C2Stage s0, s1, s2, s3, s4;
    c2_load(s0, ws, b, h, vs, lane, 0); c2_load(s1, ws, b, h, vs, lane, 1); c2_load(s2, ws, b, h, vs, lane, 2); c2_load(s3, ws, b, h, vs, lane, 3);
#pragma unroll
    for (int c = 0; c < NCH; c += 5) {
        c2_load(s4, ws, b, h, vs, lane, c + 4); c2_step(s0, Hs, ws, b, h, vs, lane, c);
        c2_load(s0, ws, b, h, vs, lane, c + 5); c2_step(s1, Hs, ws, b, h, vs, lane, c + 1);
        c2_load(s1, ws, b, h, vs, lane, c + 6); c2_step(s2, Hs, ws, b, h, vs, lane, c + 2);
        c2_load(s2, ws, b, h, vs, lane, c + 7); c2_step(s3, Hs, ws, b, h, vs, lane, c + 3);
        c2_load(s3, ws, b, h, vs, lane, c + 8); c2_step(s4, Hs, ws, b, h, vs, lane, c + 4);
    }
}
DI void phase_c3(const Args& A, int bx, int G, int wave, int lane) {
    unsigned char* ws = A.ws;
    const bf16* ZR = (const bf16*)(ws + WS_ZR); const bf16* LOG = (const bf16*)(ws + WS_LOG); const float* BON = (const float*)(ws + WS_BON); bf16* YA = (bf16*)(ws + WS_BUFA);
    const float* mu = A.in[5]; const float* lnw = A.in[14]; const float* lnb = A.in[15];
    const int half = wave >> 2, mt = wave & 3, n = lane & 15, q = lane >> 4;
    for (int wi = bx * 2 + half; wi < NITEM; wi += 2 * G) {
        const int h = wi & 15, bc = wi >> 4, c = bc % NCH, b = bc / NCH, item = (b * 16 + h) * NCH + c;
        f32x4 acc[4];
        {
            const v4u y0 = *(const v4u*)(ws + WS_Y1 + (size_t)item * 8192 + (size_t)(mt * 64 + lane) * 32), y1 = *(const v4u*)(ws + WS_Y1 + (size_t)item * 8192 + (size_t)(mt * 64 + lane) * 32 + 16);
            float t0[8], t1[8]; unpack8(y0, t0); unpack8(y1, t1);
            acc[0] = (f32x4){t0[0], t0[1], t0[2], t0[3]}; acc[1] = (f32x4){t0[4], t0[5], t0[6], t0[7]}; acc[2] = (f32x4){t1[0], t1[1], t1[2], t1[3]}; acc[3] = (f32x4){t1[4], t1[5], t1[6], t1[7]};
        }
#pragma unroll
        for (int s = 0; s < 2; ++s) {
            const v4u qf = *(const v4u*)(ws + WS_QF + (size_t)item * 8192 + (size_t)((mt * 2 + s) * 64 + lane) * 16);
#pragma unroll
            for (int vs = 0; vs < 4; ++vs) {
                const v4u hf = *(const v4u*)(ws + WS_HST + (size_t)item * 8192 + (size_t)((vs * 2 + s) * 64 + lane) * 16);
                acc[vs] = MFMA16(__builtin_bit_cast(bf16x8, qf), __builtin_bit_cast(bf16x8, hf), acc[vs]);
            }
        }
        float lw_[4], lb_[4], mv_[4];
#pragma unroll
        for (int vs = 0; vs < 4; ++vs) { const int col = h * 64 + vs * 16 + n; lw_[vs] = lnw[col]; lb_[vs] = lnb[col]; mv_[vs] = mu[2048 + col]; }
        unsigned vv_[4][4], vp_[4][4], gg_[4][4]; float bon_[4]; int row_[4]; bool ok_[4], hp_[4];
#pragma unroll
        for (int jj = 0; jj < 4; ++jj) {
            const int i = 16 * mt + 4 * q + jj, pos = c * 64 + i;
            ok_[jj] = pos < LSEQ && (pos >= NMETA || b == 0);
            const int posc = pos < LSEQ ? pos : LSEQ - 1;
            const int row = posc < NMETA ? MX + posc : b * SEQ + posc - NMETA, prow = prev_row(row);
            row_[jj] = row; hp_[jj] = prow >= 0;
            const int prc = prow >= 0 ? prow : row;
            bon_[jj] = BON[((size_t)b * (NCH * 64) + posc) * NHEAD + h];
#pragma unroll
            for (int vs = 0; vs < 4; ++vs) {
                const int col = h * 64 + vs * 16 + n;
                vv_[jj][vs] = (unsigned)ZR[(size_t)row * ZR_LD + 2048 + col];
                vp_[jj][vs] = (unsigned)ZR[(size_t)prc * ZR_LD + 2048 + col];
                gg_[jj][vs] = (unsigned)LOG[(size_t)row * 1024 + col];
            }
        }
#pragma unroll
        for (int jj = 0; jj < 4; ++jj) {
            float s1 = (acc[0][jj] + acc[1][jj]) + (acc[2][jj] + acc[3][jj]);
            s1 += __shfl_xor(s1, 1); s1 += __shfl_xor(s1, 2); s1 += __shfl_xor(s1, 4); s1 += __shfl_xor(s1, 8);
            const float mean = s1 * (1.0f / 64.0f);
            float d[4], s2 = 0.f;
#pragma unroll
            for (int vs = 0; vs < 4; ++vs) { d[vs] = acc[vs][jj] - mean; s2 += d[vs] * d[vs]; }
            s2 += __shfl_xor(s2, 1); s2 += __shfl_xor(s2, 2); s2 += __shfl_xor(s2, 4); s2 += __shfl_xor(s2, 8);
            const float rstd = __builtin_amdgcn_rsqf(s2 * (1.0f / 64.0f) + GN_EPS);
            if (ok_[jj]) {
#pragma unroll
                for (int vs = 0; vs < 4; ++vs) {
                    const int col = h * 64 + vs * 16 + n;
                    const float vv = bflo(vv_[jj][vs]), vp = hp_[jj] ? bflo(vp_[jj][vs]) : 0.f;
                    const float vsh = vv + (vp - vv) * mv_[vs];
                    const float y = (d[vs] * rstd * lw_[vs] + lb_[vs] + bon_[jj] * vsh) * bflo(gg_[jj][vs]);
                    YA[(size_t)row_[jj] * DM + 1024 + col] = (bf16)f2bf(y);
                }
            }
        }
    }
}
DI void phase4(const Args& A, int gw, int NGW, int lane) {
    unsigned char* ws = A.ws;
    const bf16* MIX = (const bf16*)(ws + WS_MIX); const float* MIXM = (const float*)(ws + WS_MIXM); bf16* N2 = (bf16*)(ws + WS_BUFA); bf16* N2M = (bf16*)(ws + WS_N2M);
    const f32x4* g1 = (const f32x4*)A.in[17] + lane; const f32x4* g2 = (const f32x4*)A.in[18] + lane;
    for (int m = gw; m < MX + 2; m += NGW) {
        const f32x4* hr = (const f32x4*)(m < MX ? A.in[0] + (size_t)m * DM : A.in[1] + (size_t)(14 + m - MX) * DM) + lane;
        f32x4 v[8], hh[8], ga[8], gb[8]; float s = 0.f;
#pragma unroll
        for (int j = 0; j < 8; ++j) { hh[j] = hr[64 * j]; ga[j] = g1[64 * j]; gb[j] = g2[64 * j]; }
        if (m < MX) { const v2u* mr = (const v2u*)(MIX + (size_t)m * DM) + lane;
#pragma unroll
            for (int j = 0; j < 8; ++j) { const v2u w = mr[64 * j]; v[j] = (f32x4){bflo(w.x), bfhi(w.x), bflo(w.y), bfhi(w.y)}; } }
        else { const f32x4* mr = (const f32x4*)(MIXM + (size_t)(m - MX) * DM) + lane;
#pragma unroll
            for (int j = 0; j < 8; ++j) v[j] = mr[64 * j]; }
#pragma unroll
        for (int j = 0; j < 8; ++j) s += (v[j].x * v[j].x + v[j].y * v[j].y) + (v[j].z * v[j].z + v[j].w * v[j].w);
        const float rs = 1.0f / sqrtf(wave_sum(s) * (1.0f / DM) + RMS_EPS);
        float s2 = 0.f;
#pragma unroll
        for (int j = 0; j < 8; ++j) { v[j] = hh[j] + v[j] * rs * ga[j]; s2 += (v[j].x * v[j].x + v[j].y * v[j].y) + (v[j].z * v[j].z + v[j].w * v[j].w); }
        const float rs2 = 1.0f / sqrtf(wave_sum(s2) * (1.0f / DM) + RMS_EPS);
        v2u* o8 = (v2u*)(m < MX ? N2 + (size_t)m * DM : N2M + (size_t)(m - MX) * DM) + lane;
#pragma unroll
        for (int j = 0; j < 8; ++j) { const f32x4 g = gb[j]; o8[64 * j] = (v2u){pk2(v[j].x * rs2 * g.x, v[j].y * rs2 * g.y), pk2(v[j].z * rs2 * g.z, v[j].w * rs2 * g.w)}; }
    }
}
DI void phase6(const Args& A, int gtid, int NT) {
    unsigned char* ws = A.ws;
    const float* G4 = (const float*)(ws + WS_G4); const float* U2 = (const float*)(ws + WS_U2); const float* GM = (const float*)(ws + WS_GM); bf16* ACT = (bf16*)(ws + WS_ACT);
    const float* cw = A.in[20];
    constexpr int C4 = DFF / 4;
    for (int idx = gtid; idx < 256 * 2 * C4; idx += NT) {
        const int c4 = idx % C4, lr = (idx / C4) & 1, rb = idx / (2 * C4), col = c4 * 4;
        const f32x4 g0 = *(const f32x4*)(G4 + (size_t)(rb * 4 + lr) * DFF + col);
        const float* pm2; const float* pm1;
        const float* pb62 = (rb % 128 == 0) ? GM + col : G4 + (size_t)((rb - 1) * 4 + 2) * DFF + col;
        const float* pb63 = (rb % 128 == 0) ? GM + DFF + col : G4 + (size_t)((rb - 1) * 4 + 3) * DFF + col;
        if (lr == 0) { pm2 = pb62; pm1 = pb63; } else { pm2 = pb63; pm1 = G4 + (size_t)(rb * 4 + 0) * DFF + col; }
        const f32x4 gm2 = *(const f32x4*)pm2, gm1 = *(const f32x4*)pm1, up = *(const f32x4*)(U2 + (size_t)(rb * 2 + lr) * DFF + col);
        const f32x4 w0 = *(const f32x4*)(cw + col), w1 = *(const f32x4*)(cw + DFF + col), w2 = *(const f32x4*)(cw + 2 * DFF + col);
        float o[4];
#pragma unroll
        for (int x = 0; x < 4; ++x) { const float cv = w0[x] * gm2[x] + w1[x] * gm1[x] + w2[x] * g0[x]; o[x] = cv * __builtin_amdgcn_rcpf(1.0f + __expf(-cv)) * up[x]; }
        *(v2u*)(ACT + (size_t)(rb * 64 + lr) * DFF + col) = (v2u){pk2(o[0], o[1]), pk2(o[2], o[3])};
    }
}
DI void phase8(const Args& A, int gw, int NGW, int lane) {
    const bf16* F = (const bf16*)(A.ws + WS_F); const bf16* MIX = (const bf16*)(A.ws + WS_MIX);
    const f32x4* g1 = (const f32x4*)A.in[17] + lane; const f32x4* g4 = (const f32x4*)A.in[22] + lane;
    for (int m = gw; m < MX; m += NGW) {
        const v2u* fr = (const v2u*)(F + (size_t)m * DM) + lane; const v2u* mr = (const v2u*)(MIX + (size_t)m * DM) + lane;
        const f32x4* xr = (const f32x4*)(A.in[0] + (size_t)m * DM) + lane; f32x4* orow = (f32x4*)(A.out + (size_t)m * DM) + lane;
        f32x4 v[8], mx[8], hx[8], ga[8], gg[8]; float s = 0.f, sm = 0.f;
#pragma unroll
        for (int j = 0; j < 8; ++j) { hx[j] = xr[64 * j]; ga[j] = g1[64 * j]; gg[j] = g4[64 * j]; }
#pragma unroll
        for (int j = 0; j < 8; ++j) { const v2u w = mr[64 * j]; mx[j] = (f32x4){bflo(w.x), bfhi(w.x), bflo(w.y), bfhi(w.y)}; sm += (mx[j].x * mx[j].x + mx[j].y * mx[j].y) + (mx[j].z * mx[j].z + mx[j].w * mx[j].w); }
#pragma unroll
        for (int j = 0; j < 8; ++j) { const v2u w = fr[64 * j]; v[j] = (f32x4){bflo(w.x), bfhi(w.x), bflo(w.y), bfhi(w.y)}; s += (v[j].x * v[j].x + v[j].y * v[j].y) + (v[j].z * v[j].z + v[j].w * v[j].w); }
        const float rsm = 1.0f / sqrtf(wave_sum(sm) * (1.0f / DM) + RMS_EPS);
        const float rs = 1.0f / sqrtf(wave_sum(s) * (1.0f / DM) + RMS_EPS);
#pragma unroll
        for (int j = 0; j < 8; ++j) orow[64 * j] = (hx[j] + mx[j] * rsm * ga[j]) + v[j] * rs * gg[j];
    }
}
__global__ void __launch_bounds__(NTHR, 2) hymba_fwd(Args args) {
    extern __shared__ __attribute__((aligned(16))) unsigned char lds[];
    cg::grid_group grid = cg::this_grid();
    const int tid = threadIdx.x, lane = tid & 63, wave = __builtin_amdgcn_readfirstlane(tid >> 6);
    const int G = gridDim.x, bx = blockIdx.x;
    const int gw = bx * NWAVES + wave, NGW = G * NWAVES;
    PG8_LAS unsigned char* ldsg = (PG8_LAS unsigned char*)lds;
#ifdef PROBE_A
    unsigned long long* stamps = (unsigned long long*)args.ws; int nst = 0;
#define STAMP() do { if (bx == 0 && tid == 0) stamps[nst] = __builtin_amdgcn_s_memrealtime(); ++nst; } while (0)
#else
#define STAMP() do { } while (0)
#endif
    STAMP();
    volatile __attribute__((address_space(3))) unsigned* MISC = (volatile __attribute__((address_space(3))) unsigned*)(ldsg + LDS_BYTES - 64);
    if (tid < 16) MISC[tid] = 0u;
    __syncthreads();
    XcdBarrier bar = xcd_barrier_post((unsigned*)(args.ws + WS_BAR), MISC + 8);
    if (args.ws == nullptr) grid.sync();

    phase0(args, lds, gw, NGW, wave, lane);
    xcd_barrier(bar); STAMP();
    {
        pg8::Gemm g{(const bf16*)(args.ws + WS_BUFA), (const bf16*)(args.ws + WS_WIN), MP, IN_PAD, DM, DM, DM}; pg8::StaticOrder S; S.init(MP, IN_PAD, G, bx);
        pg8::EpiSplit2 E{(bf16*)(args.ws + WS_ZC), ZC_LD, (bf16*)(args.ws + WS_ZR), ZR_LD, ZC_LD};
        pg8::gemm_phase<pg8::EpiSplit2, pg8::StaticOrder, true, true>(ldsg, g, S, E);
    }
    xcd_barrier(bar); STAMP();
    phase2a(args, gw, NGW, lane);
    xcd_barrier(bar); STAMP();
    {
        if (wave == 0 && bx < 192) {
            const int n0 = bx * 16, seg = n0 >> 10, r16 = lane & 15, q = lane >> 4;
            const bf16* LAx = (const bf16*)(args.ws + (seg == 2 ? WS_LA2 : WS_LA1)); const bf16* WLx = seg == 2 ? (const bf16*)(args.ws + WS_WL2) + (size_t)(n0 - 2048) * 256 : (const bf16*)(args.ws + WS_WL1) + (size_t)n0 * 256;
            const int ks0 = seg == 1 ? 4 : 0, nks = seg == 2 ? 8 : 3;
            v4u af[8], bfr[8];
#pragma unroll
            for (int s = 0; s < 8; ++s) { const int sc = s < nks ? s : 0;
                af[s] = *(const v4u*)(LAx + (size_t)(MX + r16) * 256 + (ks0 + sc) * 32 + q * 8); bfr[s] = *(const v4u*)(WLx + (size_t)r16 * 256 + (ks0 + sc) * 32 + q * 8); }
            f32x4 acc = (f32x4){0.f, 0.f, 0.f, 0.f};
#pragma unroll
            for (int s = 0; s < 8; ++s) if (s < nks) acc = MFMA16(__builtin_bit_cast(bf16x8, af[s]), __builtin_bit_cast(bf16x8, bfr[s]), acc);
            bf16* dst = n0 < 2048 ? (bf16*)(args.ws + WS_LODA) : (bf16*)(args.ws + WS_LOG); const int ldd = n0 < 2048 ? 2048 : 1024, nc = (n0 < 2048 ? n0 : n0 - 2048) + r16;
#pragma unroll
            for (int jj = 0; jj < 4; ++jj) dst[(size_t)(MX + 4 * q + jj) * ldd + nc] = (bf16)f2bf(acc[jj]);
        }
        {
            pg8::Gemm g{(const bf16*)(args.ws + WS_LA1), (const bf16*)(args.ws + WS_WL1), MX, 2048, 256, 256, 256}; pg8::StaticOrder S; S.init(MX, 2048, G, bx);
            pg8::EpiSplit2 E{(bf16*)(args.ws + WS_LODA), 2048, nullptr, 0, 1 << 30};
            pg8::gemm_phase<pg8::EpiSplit2, pg8::StaticOrder, true, true>(ldsg, g, S, E);
        }
        {
            pg8::Gemm g{(const bf16*)(args.ws + WS_LA2), (const bf16*)(args.ws + WS_WL2), MX, 1024, 256, 256, 256}; pg8::StaticOrder S; S.init(MX, 1024, G, bx);
            pg8::EpiSplit2 E{(bf16*)(args.ws + WS_LOG), 1024, nullptr, 0, 1 << 30};
            pg8::gemm_phase<pg8::EpiSplit2, pg8::StaticOrder, true, true>(ldsg, g, S, E);
        }
    }
    xcd_barrier(bar); STAMP();
    phase_c1(args, lds, bx, G, tid, wave, lane);
    xcd_barrier(bar); STAMP();
    if (bx < 32) { if (wave < 4) phase_c2(args, bx, wave, lane);
#ifdef PROBE_A
        if (bx == 0 && tid == 0) stamps[20] = __builtin_amdgcn_s_memrealtime();
#endif
    }
    else {
        convert_late(args, lds, (bx - 32) * NWAVES + wave, (G - 32) * NWAVES, wave, lane);
        __syncthreads();
        pg8::Gemm g{(const bf16*)(args.ws + WS_BUFA), (const bf16*)(args.ws + WS_WOUT), MX, DM, KSPLIT, DM, DM}; pg8::StaticOrder S; S.init(MX, DM, G - 32, bx - 32);
        pg8::EpiSplit2 E{(bf16*)args.out, DM, nullptr, 0, 1 << 30};
        pg8::gemm_phase<pg8::EpiSplit2, pg8::StaticOrder, true, true>(ldsg, g, S, E);
    }
    xcd_barrier(bar); STAMP();
    phase_c3(args, bx, G, wave, lane);
    xcd_barrier(bar); STAMP();
    {
        const bf16* YA = (const bf16*)(args.ws + WS_BUFA); const bf16* WOUT = (const bf16*)(args.ws + WS_WOUT); float* MIXM = (float*)(args.ws + WS_MIXM);
        for (int n = gw; n < DM; n += NGW) { const bf16* const br[1] = {WOUT + (size_t)n * DM}; float o0[1], o1[1];
            gemv2_rows<1>(YA + (size_t)(MX + 14) * DM, YA + (size_t)(MX + 15) * DM, br, lane, o0, o1); if (lane == 0) { MIXM[n] = o0[0]; MIXM[DM + n] = o1[0]; } }
        pg8::Gemm g{YA + KSPLIT, WOUT + KSPLIT, MX, DM, DM - KSPLIT, DM, DM}; pg8::StaticOrder S; S.init(MX, DM, G, bx);
        pg8::EpiAddBf16 E{(const bf16*)args.out, (bf16*)(args.ws + WS_MIX), DM};
        pg8::gemm_phase<pg8::EpiAddBf16, pg8::StaticOrder, true, true>(ldsg, g, S, E);
    }
    xcd_barrier(bar); STAMP();
    phase4(args, gw, NGW, lane);
    xcd_barrier(bar); STAMP();
    {
        const bf16* N2 = (const bf16*)(args.ws + WS_BUFA); const bf16* N2M = (const bf16*)(args.ws + WS_N2M); const bf16* WGU = (const bf16*)(args.ws + WS_WGU); float* GM = (float*)(args.ws + WS_GM);
        if (gw < DFF) {
            int jc[3]; const bf16* br[3]; float o0[3], o1[3];
#pragma unroll
            for (int c = 0; c < 3; ++c) { const int j = gw + c * NGW; jc[c] = j < DFF ? j : gw; br[c] = WGU + (size_t)(256 * (jc[c] >> 7) + (jc[c] & 127)) * DM; }
            gemv2_rows<3>(N2M, N2M + DM, br, lane, o0, o1);
            if (lane == 0) {
#pragma unroll
                for (int c = 0; c < 3; ++c) if (gw + c * NGW < DFF) { GM[jc[c]] = o0[c]; GM[DFF + jc[c]] = o1[c]; } }
        }
        pg8::Gemm g{N2, WGU, MX, 2 * DFF, DM, DM, DM}; pg8::StaticOrder S; S.init(MX, 2 * DFF, G, bx);
        pg8::EpiAct E{(bf16*)(args.ws + WS_ACT), (float*)(args.ws + WS_G4), (float*)(args.ws + WS_U2), args.in[20], DFF};
        pg8::gemm_phase<pg8::EpiAct, pg8::StaticOrder, true, true>(ldsg, g, S, E);
    }
    xcd_barrier(bar); STAMP();
    phase6(args, bx * NTHR + tid, G * NTHR);
    xcd_barrier(bar); STAMP();
    {
        pg8::Gemm g{(const bf16*)(args.ws + WS_ACT), (const bf16*)(args.ws + WS_WDN), MX, DM, DFF, DFF, DFF}; pg8::StaticOrder S; S.init(MX, DM, G, bx);
        pg8::EpiSplit2 E{(bf16*)(args.ws + WS_F), DM, nullptr, 0, 1 << 30};
        pg8::gemm_phase<pg8::EpiSplit2, pg8::StaticOrder, true, true>(ldsg, g, S, E);
    }
    xcd_barrier(bar); STAMP();
    phase8(args, gw, NGW, lane);
#ifdef PROBE_A
    xcd_barrier(bar); STAMP();
    if (bx == 0) {
        const float ta = PROBE_A == 100 ? (float)(stamps[20] - stamps[5]) * 0.01f : (float)(stamps[PROBE_A + 1] - stamps[PROBE_A]) * 0.01f;
        if (tid == 0) args.out[0] = ta * PROBE_SCALE;
    }
#endif
}

extern "C" void kernel_launch(void* const* d_in, const int* in_sizes, int n_in, void* d_out, int out_size, void* d_ws, size_t ws_size, hipStream_t stream) {
    static int grid = 0;
    if (grid == 0) {
        if (n_in != 23 || out_size != MX * DM || ws_size < WS_END) { fprintf(stderr, "kernel_launch: unexpected shapes (n_in %d, out %d, ws %zu)\n", n_in, out_size, ws_size); grid = -1; return; }
        int dev = 0, cus = 0, per_cu = 0;
        if (hipGetDevice(&dev) != hipSuccess || hipDeviceGetAttribute(&cus, hipDeviceAttributeMultiprocessorCount, dev) != hipSuccess) { grid = -1; return; }
        if (hipFuncSetAttribute((const void*)hymba_fwd, hipFuncAttributeMaxDynamicSharedMemorySize, LDS_BYTES) != hipSuccess) { fprintf(stderr, "kernel_launch: hipFuncSetAttribute failed\n"); grid = -1; return; }
        if (hipOccupancyMaxActiveBlocksPerMultiprocessor(&per_cu, (const void*)hymba_fwd, NTHR, LDS_BYTES) != hipSuccess || per_cu < 1) { fprintf(stderr, "kernel_launch: occupancy query says %d\n", per_cu); per_cu = 1; }
        (void)hipGetLastError();
        grid = (cus / 16) * 16;
        if (grid < 240) { fprintf(stderr, "kernel_launch: needs >= 240 CUs\n"); grid = -1; return; }
    }
    if (grid < 0) return;
    if (hipMemsetAsync((char*)d_ws, 0, 131072, stream) != hipSuccess) { fprintf(stderr, "kernel_launch: memset failed\n"); return; }
    Args a{};
    for (int i = 0; i < 23; ++i) a.in[i] = (const float*)d_in[i];
    a.out = (float*)d_out; a.ws = (unsigned char*)d_ws;
    void* kargs[] = {&a};
    hipError_t e = hipLaunchCooperativeKernel((const void*)hymba_fwd, dim3(grid), dim3(NTHR), kargs, LDS_BYTES, stream);
    if (e != hipSuccess) fprintf(stderr, "kernel_launch: cooperative launch failed: %s (grid %d)\n", hipGetErrorString(e), grid);
}
```

```cpp
#include <hip/hip_runtime.h>
#include <hip/hip_cooperative_groups.h>
#include <cstdio>
#include <cstdint>
namespace cg = cooperative_groups;
namespace pg8 {
#define PG8_LAS __attribute__((address_space(3)))
typedef unsigned short bf16_t;
typedef short bf16x8 __attribute__((ext_vector_type(8)));
typedef float f32x4 __attribute__((ext_vector_type(4)));
typedef unsigned u32x4 __attribute__((ext_vector_type(4)));
constexpr int BM = 256, BK = 64, HALF = 128, HTB = HALF * BK * 2  , STAGE_BYTES = 8 * HTB, NXCD = 8, WGM = 8;

__host__ __device__ __forceinline__ int lds_byte(int r, int c) { const int st = (r >> 4) * 2 + (c >> 5), rr = r & 15, cc = c & 31, ob = rr * 64 + cc * 2; return st * 1024 + (ob ^ (((ob >> 9) & 1) << 5)); }
__host__ __device__ __forceinline__ void stage_rc(int b, int& R, int& C) { const int st = b / 1024, sb = b % 1024, swz = sb ^ (((sb >> 9) & 1) << 5); R = (st >> 1) * 16 + swz / 64; C = (st & 1) * 32 + (swz % 64) / 2; }
__host__ __device__ __forceinline__ int perm32(int rho) { const int n = rho >> 4, i = rho & 15; return 8 * (i >> 2) + 4 * n + (i & 3); }

struct Unit { int pm, pn; };
struct Gemm { const bf16_t* A; const bf16_t* Bt; int M, N, K, lda, ldb; };

struct StaticOrder {
    int nM, nN, nwg, G, c;
    __host__ __device__ void init(int M, int N, int G_, int c_) { nM = M / BM; nN = N / BM; nwg = nM * nN; G = G_; c = c_; }
    __host__ __device__ bool next(int i, Unit& u) const {
        const long L = (long)i * G + c; if (L >= nwg) return false;
        int wgid = (int)L; { const int q = nwg / NXCD, r = nwg % NXCD, xcd = wgid % NXCD, off = wgid / NXCD; wgid = (xcd < r ? xcd * (q + 1) : r * (q + 1) + (xcd - r) * q) + off; }
        const int nig = WGM * nN, gid = wgid / nig, fm = gid * WGM, gsz = (nM - fm) < WGM ? (nM - fm) : WGM;
        u.pm = fm + ((wgid % nig) % gsz); u.pn = (wgid % nig) / gsz; return true;
    }
    __device__ __forceinline__ void a_ready(const Unit&) const {}
    __device__ __forceinline__ void done(const Unit&) const {}
};
__device__ __forceinline__ unsigned cvt_pk_bf16(float lo, float hi) { unsigned r; asm volatile("v_cvt_pk_bf16_f32 %0, %1, %2" : "=v"(r) : "v"(lo), "v"(hi)); return r; }
template <class Epi, class Sched, bool ALIGN_EPI = false, bool SP2 = false>
__device__ __forceinline__ void gemm_phase(PG8_LAS unsigned char* lds, const Gemm g, const Sched& S, const Epi& E) {
    int tid_ = threadIdx.x; asm volatile("" : "+v"(tid_));
    const int tid = tid_, wid = __builtin_amdgcn_readfirstlane(tid >> 6), lane = tid & 63, wr = wid >> 2, wc = wid & 3, fr = lane & 15, fq = lane >> 4;
    const int K = g.K, nt = K / BK;
    unsigned voffA[2], voffB[2];
#pragma unroll
    for (int i = 0; i < 2; ++i) { int R, C; stage_rc(tid * 16 + i * 8192, R, C); const int Rb = Epi::PERM ? ((R & ~31) + perm32(R & 31)) : R;
        voffA[i] = (unsigned)(R * g.lda + C) * 2u; voffB[i] = (unsigned)(Rb * g.ldb + C) * 2u; }
    const size_t kstep = (size_t)(BK * 2);
    const size_t hstepA = (size_t)HALF * g.lda * 2, hstepB = (size_t)HALF * g.ldb * 2;
    const size_t tstepA = 2 * hstepA, tstepB = 2 * hstepB;
    const unsigned ldsw = (unsigned)wid * 1024u;
    const int aoff = lds_byte(wr * 64 + fr, fq * 8), boff = lds_byte(wc * 32 + fr, fq * 8);
#define PG8_SA(b, h) (((b) * 2 + (h)) * HTB)
#define PG8_SB(b, h) ((4 + (b) * 2 + (h)) * HTB)
#define PG8_STAGE(bufoff, gbase, voff) do { _Pragma("unroll") for (int _i = 0; _i < 2; ++_i) \
        __builtin_amdgcn_global_load_lds((const unsigned*)((const char*)(gbase) + (voff)[_i]), (PG8_LAS unsigned*)(lds + (bufoff) + ldsw + _i * 8192), 16, 0, 0); } while (0)
#define PG8_LDA(dst, b, h) do { _Pragma("unroll") for (int m = 0; m < 4; ++m) _Pragma("unroll") for (int k = 0; k < 2; ++k) dst[m][k] = *(const PG8_LAS bf16x8*)(lds + PG8_SA(b, h) + aoff + m * 2048 + k * 1024); } while (0)
#define PG8_LDB(dst, b, h) do { _Pragma("unroll") for (int n = 0; n < 2; ++n) _Pragma("unroll") for (int k = 0; k < 2; ++k) dst[n][k] = *(const PG8_LAS bf16x8*)(lds + PG8_SB(b, h) + boff + n * 2048 + k * 1024); } while (0)
#define PG8_MMA(ai, bj, At, Bt) do { __builtin_amdgcn_s_setprio(1); _Pragma("unroll") for (int m = 0; m < 4; ++m) _Pragma("unroll") for (int n = 0; n < 2; ++n) _Pragma("unroll") for (int k = 0; k < 2; ++k) \
        acc[ai][bj][m][n] = __builtin_amdgcn_mfma_f32_16x16x32_bf16(Bt[n][k], At[m][k], acc[ai][bj][m][n], 0, 0, 0); __builtin_amdgcn_s_setprio(0); } while (0)
#define PG8_WAIT_V(n) asm volatile("s_waitcnt vmcnt(" #n ")" ::: "memory")
#define PG8_WAIT_L(n) asm volatile("s_waitcnt lgkmcnt(" #n ")" ::: "memory")
#define PG8_BAR __builtin_amdgcn_s_barrier()
#define PG8_SCHED __builtin_amdgcn_sched_barrier(0)
    Unit cur, nxt; int ui = 0;
    if (!S.next(0, cur)) return;
    f32x4 acc[2][2][4][2];
#pragma unroll
    for (int a = 0; a < 2; ++a)
#pragma unroll
        for (int b = 0; b < 2; ++b)
#pragma unroll
            for (int m = 0; m < 4; ++m)
#pragma unroll
                for (int n = 0; n < 2; ++n) acc[a][b][m][n] = (f32x4){0.f, 0.f, 0.f, 0.f};
    bf16x8 At[4][2], B0[2][2], B1[2][2];
    const char* cA = (const char*)g.A + (size_t)cur.pm * tstepA; const char* cB = (const char*)g.Bt + (size_t)cur.pn * tstepB;
    S.a_ready(cur);
    if constexpr (SP2) {
        PG8_STAGE(PG8_SB(0, 0), cB, voffB); PG8_STAGE(PG8_SB(0, 1), cB + hstepB, voffB); PG8_STAGE(PG8_SA(0, 0), cA, voffA); PG8_STAGE(PG8_SA(0, 1), cA + hstepA, voffA);
        if (wr == 1) PG8_BAR;
        PG8_WAIT_V(2); PG8_BAR;
        PG8_STAGE(PG8_SB(1, 0), cB + kstep, voffB); PG8_STAGE(PG8_SA(1, 0), cA + kstep, voffA); PG8_STAGE(PG8_SB(1, 1), cB + hstepB + kstep, voffB);
        PG8_WAIT_V(6); PG8_BAR;
    } else {
        PG8_STAGE(PG8_SB(0, 0), cB, voffB); PG8_STAGE(PG8_SA(0, 0), cA, voffA); PG8_STAGE(PG8_SB(0, 1), cB + hstepB, voffB); PG8_STAGE(PG8_SA(0, 1), cA + hstepA, voffA);
        if (wr == 1) PG8_BAR;
        PG8_WAIT_V(4); PG8_BAR;
        PG8_STAGE(PG8_SB(1, 0), cB + kstep, voffB); PG8_STAGE(PG8_SA(1, 0), cA + kstep, voffA); PG8_STAGE(PG8_SB(1, 1), cB + hstepB + kstep, voffB);
        PG8_WAIT_V(6); PG8_BAR;
    }
    for (;;) {
        const bool has_next = S.next(ui + 1, nxt);
        const char* nA = has_next ? (const char*)g.A + (size_t)nxt.pm * tstepA : cA; const char* nB = has_next ? (const char*)g.Bt + (size_t)nxt.pn * tstepB : cB;
        for (int t = 0; t < nt; t += 2) {
            const bool last = (t == nt - 2);
            const char* a1 = cA + (size_t)(t + 1) * kstep;
            const char* a2 = last ? nA : cA + (size_t)(t + 2) * kstep; const char* b2 = last ? nB : cB + (size_t)(t + 2) * kstep;
            const char* a3 = a2 + kstep; const char* b3 = b2 + kstep;
            if (last && has_next) S.a_ready(nxt);
            if constexpr (SP2) {
            PG8_LDB(B0, 0, 0); PG8_LDB(B1, 0, 1); PG8_SCHED; PG8_LDA(At, 0, 0); PG8_STAGE(PG8_SA(1, 1), a1 + hstepA, voffA);
            PG8_WAIT_V(8); PG8_WAIT_L(0); PG8_BAR; PG8_MMA(0, 0, At, B0); PG8_MMA(0, 1, At, B1); PG8_BAR; PG8_SCHED;
            PG8_LDA(At, 0, 1); PG8_STAGE(PG8_SB(0, 0), b2, voffB); PG8_STAGE(PG8_SB(0, 1), b2 + hstepB, voffB); PG8_STAGE(PG8_SA(0, 0), a2, voffA);
            PG8_WAIT_V(8); PG8_WAIT_L(0); PG8_BAR; PG8_MMA(1, 0, At, B0); PG8_MMA(1, 1, At, B1); PG8_BAR; PG8_SCHED;
            PG8_LDB(B0, 1, 0); PG8_LDB(B1, 1, 1); PG8_SCHED; PG8_LDA(At, 1, 0); PG8_STAGE(PG8_SA(0, 1), a2 + hstepA, voffA);
            PG8_WAIT_V(8); PG8_WAIT_L(0); PG8_BAR; PG8_MMA(0, 0, At, B0); PG8_MMA(0, 1, At, B1); PG8_BAR; PG8_SCHED;
            PG8_LDA(At, 1, 1); PG8_STAGE(PG8_SB(1, 0), b3, voffB); PG8_STAGE(PG8_SB(1, 1), b3 + hstepB, voffB); PG8_STAGE(PG8_SA(1, 0), a3, voffA);
            PG8_WAIT_V(8); PG8_WAIT_L(0); PG8_BAR; PG8_MMA(1, 0, At, B0); PG8_MMA(1, 1, At, B1); PG8_BAR; PG8_SCHED;
            } else {
            PG8_LDB(B0, 0, 0); PG8_SCHED; PG8_LDA(At, 0, 0); PG8_STAGE(PG8_SA(1, 1), a1 + hstepA, voffA);
            PG8_WAIT_L(8); PG8_BAR; PG8_WAIT_L(0); PG8_MMA(0, 0, At, B0); PG8_BAR; PG8_SCHED;
            PG8_LDB(B1, 0, 1); PG8_STAGE(PG8_SB(0, 0), b2, voffB);
            PG8_BAR; PG8_WAIT_L(0); PG8_MMA(0, 1, At, B1); PG8_BAR;
            PG8_LDA(At, 0, 1); PG8_STAGE(PG8_SA(0, 0), a2, voffA);
            PG8_BAR; PG8_WAIT_L(0); PG8_MMA(1, 0, At, B0); PG8_BAR; PG8_SCHED;
            PG8_STAGE(PG8_SB(0, 1), b2 + hstepB, voffB);
            PG8_WAIT_V(6); PG8_BAR; PG8_MMA(1, 1, At, B1); PG8_BAR;
            PG8_LDB(B0, 1, 0); PG8_SCHED; PG8_LDA(At, 1, 0); PG8_STAGE(PG8_SA(0, 1), a2 + hstepA, voffA);
            PG8_WAIT_L(8); PG8_BAR; PG8_WAIT_L(0); PG8_MMA(0, 0, At, B0); PG8_BAR; PG8_SCHED;
            PG8_LDB(B1, 1, 1); PG8_STAGE(PG8_SB(1, 0), b3, voffB);
            PG8_BAR; PG8_WAIT_L(0); PG8_MMA(0, 1, At, B1); PG8_BAR;
            PG8_LDA(At, 1, 1); PG8_STAGE(PG8_SA(1, 0), a3, voffA);
            PG8_BAR; PG8_WAIT_L(0); PG8_MMA(1, 0, At, B0); PG8_BAR; PG8_SCHED;
            PG8_STAGE(PG8_SB(1, 1), b3 + hstepB, voffB);
            PG8_WAIT_V(6); PG8_BAR; PG8_MMA(1, 1, At, B1); PG8_BAR;
            }
        }
        if constexpr (ALIGN_EPI) { if (wr == 0) PG8_BAR; }
        if constexpr (!Epi::AFTER_DRAIN) { E(acc, cur, wr, wc, fr, fq); S.done(cur); }
        if (!has_next) break;
#pragma unroll
        for (int a = 0; a < 2; ++a)
#pragma unroll
            for (int b = 0; b < 2; ++b)
#pragma unroll
                for (int m = 0; m < 4; ++m)
#pragma unroll
                    for (int n = 0; n < 2; ++n) acc[a][b][m][n] = (f32x4){0.f, 0.f, 0.f, 0.f};
        cur = nxt; cA = nA; cB = nB; ++ui;
        if constexpr (ALIGN_EPI) { if (wr == 1) PG8_BAR; }
    }
    PG8_WAIT_V(0);
    if constexpr (!ALIGN_EPI) { if (wr == 0) PG8_BAR; }
    PG8_BAR;
    if constexpr (Epi::AFTER_DRAIN) { E.fused(acc, cur, wr, wc, fr, fq, lds, wid, lane); S.done(cur); }
#undef PG8_SA
#undef PG8_SB
#undef PG8_STAGE
#undef PG8_LDA
#undef PG8_LDB
#undef PG8_MMA
#undef PG8_WAIT_V
#undef PG8_WAIT_L
#undef PG8_BAR
#undef PG8_SCHED
}
struct EpiSplit2 {
    static constexpr bool PERM = true, AFTER_DRAIN = false;
    bf16_t* O0; int ld0; bf16_t* O1; int ld1; int split_col;
    __device__ __forceinline__ void operator()(const f32x4 (&acc)[2][2][4][2], const Unit& u, int wr, int wc, int fr, int fq) const {
        const int row0 = u.pm * BM + wr * 64 + fr; int colt = u.pn * BM; bf16_t* base = O0; int ldc = ld0;
        if (colt >= split_col) { base = O1; ldc = ld1; colt -= split_col; }
        const int col0 = colt + wc * 32 + 8 * fq;
#pragma unroll
        for (int ai = 0; ai < 2; ++ai)
#pragma unroll
            for (int m = 0; m < 4; ++m) { bf16_t* rowp = base + (size_t)(row0 + ai * HALF + m * 16) * ldc + col0;
#pragma unroll
                for (int bj = 0; bj < 2; ++bj) { const f32x4 v0 = acc[ai][bj][m][0], v1 = acc[ai][bj][m][1];
                    u32x4 w; w.x = cvt_pk_bf16(v0[0], v0[1]); w.y = cvt_pk_bf16(v0[2], v0[3]); w.z = cvt_pk_bf16(v1[0], v1[1]); w.w = cvt_pk_bf16(v1[2], v1[3]);
                    *(u32x4*)(rowp + bj * HALF) = w; } }
    }
};
struct EpiF32 {
    static constexpr bool PERM = false, AFTER_DRAIN = false;
    float* C; int ldc;
    __device__ __forceinline__ void operator()(const f32x4 (&acc)[2][2][4][2], const Unit& u, int wr, int wc, int fr, int fq) const {
        const int row0 = u.pm * BM + wr * 64 + fr, col0 = u.pn * BM + wc * 32 + 4 * fq;
#pragma unroll
        for (int ai = 0; ai < 2; ++ai)
#pragma unroll
            for (int m = 0; m < 4; ++m) { float* rowp = C + (size_t)(row0 + ai * HALF + m * 16) * ldc + col0;
#pragma unroll
                for (int bj = 0; bj < 2; ++bj)
#pragma unroll
                    for (int n = 0; n < 2; ++n) *(f32x4*)(rowp + bj * HALF + n * 16) = acc[ai][bj][m][n]; }
    }
};
struct EpiAct {
    static constexpr bool PERM = true, AFTER_DRAIN = false;
    bf16_t* ACT; float* G4; float* U2; const float* cw; int dff;
    __device__ __forceinline__ void operator()(const f32x4 (&acc)[2][2][4][2], const Unit& u, int wr, int wc, int fr, int fq) const {
        const int lane = (int)(threadIdx.x & 63);
        const int colg = u.pn * HALF + wc * 32 + 8 * fq;
        const int src1 = (lane & 48) | ((fr + 15) & 15), src2 = (lane & 48) | ((fr + 14) & 15);
        f32x4 w0[2], w1[2], w2[2];
#pragma unroll
        for (int n = 0; n < 2; ++n) { w0[n] = *(const f32x4*)(cw + colg + 4 * n); w1[n] = *(const f32x4*)(cw + dff + colg + 4 * n); w2[n] = *(const f32x4*)(cw + 2 * dff + colg + 4 * n); }
#pragma unroll
        for (int ai = 0; ai < 2; ++ai) {
            const int rowb = u.pm * BM + ai * HALF + wr * 64;
            const int rb = rowb >> 6;
            f32x4 c1[2], c2[2];
#pragma unroll
            for (int n = 0; n < 2; ++n) { c1[n] = (f32x4){0.f, 0.f, 0.f, 0.f}; c2[n] = c1[n]; }
#pragma unroll
            for (int m = 0; m < 4; ++m) {
                u32x4 wout; unsigned pk[4];
#pragma unroll
                for (int n = 0; n < 2; ++n) {
                    const f32x4 g = acc[ai][0][m][n], up = acc[ai][1][m][n];
                    f32x4 s1, s2, o;
#pragma unroll
                    for (int x = 0; x < 4; ++x) { s1[x] = __shfl(g[x], src1); s2[x] = __shfl(g[x], src2); }
#pragma unroll
                    for (int x = 0; x < 4; ++x) {
                        const float p1 = fr >= 1 ? s1[x] : c1[n][x], p2 = fr >= 2 ? s2[x] : c2[n][x];
                        const float cv = w0[n][x] * p2 + w1[n][x] * p1 + w2[n][x] * g[x];
                        o[x] = cv * __builtin_amdgcn_rcpf(1.0f + __expf(-cv)) * up[x];
                    }
                    c1[n] = s1; c2[n] = s2;
                    pk[2 * n] = cvt_pk_bf16(o[0], o[1]); pk[2 * n + 1] = cvt_pk_bf16(o[2], o[3]);
                    if (m == 0 && fr < 2) { *(f32x4*)(G4 + (size_t)(rb * 4 + fr) * dff + colg + 4 * n) = g; *(f32x4*)(U2 + (size_t)(rb * 2 + fr) * dff + colg + 4 * n) = up; }
                    if (m == 3 && fr >= 14) { *(f32x4*)(G4 + (size_t)(rb * 4 + 2 + (fr - 14)) * dff + colg + 4 * n) = g; }
                }
                wout.x = pk[0]; wout.y = pk[1]; wout.z = pk[2]; wout.w = pk[3];
                *(u32x4*)(ACT + (size_t)(rowb + m * 16 + fr) * dff + colg) = wout;
            }
        }
    }
};
struct EpiAddBf16 {
    static constexpr bool PERM = true, AFTER_DRAIN = false;
    const bf16_t* P; bf16_t* O; int ldc;
    __device__ __forceinline__ void operator()(const f32x4 (&acc)[2][2][4][2], const Unit& u, int wr, int wc, int fr, int fq) const {
        const int row0 = u.pm * BM + wr * 64 + fr, col0 = u.pn * BM + wc * 32 + 8 * fq;
#pragma unroll
        for (int ai = 0; ai < 2; ++ai)
#pragma unroll
            for (int m = 0; m < 4; ++m) { const size_t off = (size_t)(row0 + ai * HALF + m * 16) * ldc + col0;
#pragma unroll
                for (int bj = 0; bj < 2; ++bj) { const f32x4 v0 = acc[ai][bj][m][0], v1 = acc[ai][bj][m][1];
                    const u32x4 p = *(const u32x4*)(P + off + bj * HALF);
                    u32x4 w;
                    w.x = cvt_pk_bf16(v0[0] + __builtin_bit_cast(float, p.x << 16), v0[1] + __builtin_bit_cast(float, p.x & 0xffff0000u));
                    w.y = cvt_pk_bf16(v0[2] + __builtin_bit_cast(float, p.y << 16), v0[3] + __builtin_bit_cast(float, p.y & 0xffff0000u));
                    w.z = cvt_pk_bf16(v1[0] + __builtin_bit_cast(float, p.z << 16), v1[1] + __builtin_bit_cast(float, p.z & 0xffff0000u));
                    w.w = cvt_pk_bf16(v1[2] + __builtin_bit_cast(float, p.w << 16), v1[3] + __builtin_bit_cast(float, p.w & 0xffff0000u));
                    *(u32x4*)(O + off + bj * HALF) = w; } }
    }
};
}
constexpr int DM = 2048, NBATCH = 2, SEQ = 8192, NMETA = 16;
constexpr int MX = NBATCH * SEQ;
constexpr int MROWS = MX + NMETA;
constexpr int MP = 16640;
constexpr int LSEQ = SEQ + NMETA;
constexpr int NCH = 129;
constexpr int NHEAD = 16;
constexpr int IN_COLS = 6592, IN_PAD = 6656, ZC_LD = 3072, ZR_LD = 3584;
constexpr int DFF = 5632;
constexpr int NITEM = NBATCH * NCH * NHEAD;
constexpr float RMS_EPS = 1e-6f, GN_EPS = 64e-5f, DECAY_SCALE = 0.60653065971263342f;
constexpr int NWAVES = 8, NTHR = 512;
constexpr int LDS_BYTES = 147456;
constexpr size_t MiB = 1u << 20;
constexpr size_t WS_BAR = 65536;
constexpr size_t WS_WIN = 1 * MiB, WS_WOUT = 27 * MiB, WS_WLORA = 35 * MiB, WS_BUFA = 38 * MiB;
constexpr size_t WS_ZR = 103 * MiB, WS_LODA = 217 * MiB, WS_LOG = 282 * MiB, WS_ZC = 315 * MiB, WS_LA = 413 * MiB;
constexpr size_t WS_LA1 = WS_LA, WS_LA2 = WS_LA + (size_t)MP * 256 * 2, WS_WL1 = WS_WLORA, WS_WL2 = WS_WLORA + (size_t)2048 * 256 * 2;
constexpr size_t WS_MF = 315 * MiB, C1ARR = (size_t)NITEM * 8192, WS_QF = WS_MF + C1ARR, WS_NB = WS_QF + C1ARR, WS_Y1 = WS_NB + C1ARR;
constexpr size_t WS_HST = 444 * MiB, WS_BON = 476 * MiB + 512 * 1024;
constexpr size_t WS_WGU = 217 * MiB, WS_WDN = 478 * MiB;
constexpr size_t WS_MIX = 103 * MiB, WS_ACT = 262 * MiB, WS_G4 = 438 * MiB, WS_U2 = 460 * MiB, WS_F = 167 * MiB;
constexpr size_t WS_MIXM = 501 * MiB, WS_N2M = 501 * MiB + 256 * 1024, WS_GM = 501 * MiB + 512 * 1024, WS_END = 502 * MiB;
static_assert(WS_Y1 + C1ARR <= WS_HST && WS_HST + C1ARR <= WS_BON && WS_BON + (size_t)NBATCH * NCH * 64 * NHEAD * 4 <= WS_WDN, "ws map");

typedef unsigned short bf16;
typedef unsigned v4u __attribute__((ext_vector_type(4)));
typedef unsigned v2u __attribute__((ext_vector_type(2)));
typedef float f32x4 __attribute__((ext_vector_type(4)));
typedef short bf16x8 __attribute__((ext_vector_type(8)));
#define LDS_WAIT() asm volatile("s_waitcnt lgkmcnt(0)" ::: "memory")
#define DI __device__ __forceinline__
typedef float f32x2_t __attribute__((ext_vector_type(2)));
typedef __bf16 bf16x2_t __attribute__((ext_vector_type(2)));
DI unsigned pk2(float lo, float hi) { const f32x2_t v = {lo, hi}; const bf16x2_t r = __builtin_convertvector(v, bf16x2_t); return __builtin_bit_cast(unsigned, r); }
DI unsigned f2bf(float f) { return pk2(f, 0.f) & 0xffffu; }
DI float bflo(unsigned w) { return __builtin_bit_cast(float, w << 16); }
DI float bfhi(unsigned w) { return __builtin_bit_cast(float, w & 0xffff0000u); }
DI float bf2f(bf16 b) { return __builtin_bit_cast(float, ((unsigned)b) << 16); }
DI void unpack8(const v4u w, float (&o)[8]) { o[0] = bflo(w.x); o[1] = bfhi(w.x); o[2] = bflo(w.y); o[3] = bfhi(w.y); o[4] = bflo(w.z); o[5] = bfhi(w.z); o[6] = bflo(w.w); o[7] = bfhi(w.w); }
DI v4u pack8(const float (&o)[8]) { v4u w; w.x = pk2(o[0], o[1]); w.y = pk2(o[2], o[3]); w.z = pk2(o[4], o[5]); w.w = pk2(o[6], o[7]); return w; }
DI float sigmoidf_(float x) { return __builtin_amdgcn_rcpf(1.0f + __expf(-x)); }
DI float wave_sum(float v) {
#pragma unroll
    for (int o = 1; o < 64; o <<= 1) v += __shfl_xor(v, o);
    return v;
}
DI int prev_row(int t) { if (t >= MX) return t == MX ? -1 : t - 1; return (t % SEQ == 0) ? (MX + NMETA - 1) : t - 1; }

struct Args { const float* in[23]; float* out; unsigned char* ws; };

DI void tr_item(const float* W, int N, bf16* WT, int Kd, int k0, int n0, int drow0, float* scr, int lane) {
    float tv[64];
#pragma unroll
    for (int i = 0; i < 64; ++i) tv[i] = W[(size_t)(k0 + i) * N + n0 + lane];
#pragma unroll
    for (int i = 0; i < 64; ++i) scr[i * 65 + lane] = tv[i];
    LDS_WAIT();
    const int c = lane & 7;
#pragma unroll
    for (int j = 0; j < 8; ++j) { const int n = (lane >> 3) + 8 * j; const float* s = scr + (8 * c) * 65 + n;
        v4u o; o.x = pk2(s[0 * 65], s[1 * 65]); o.y = pk2(s[2 * 65], s[3 * 65]); o.z = pk2(s[4 * 65], s[5 * 65]); o.w = pk2(s[6 * 65], s[7 * 65]);
        *(v4u*)(WT + (size_t)(drow0 + n) * Kd + k0 + 8 * c) = o; }
    LDS_WAIT();
}
DI void rms_row_bf16(const float* src, const float* gain, bf16* dst, int lane) {
    v2u* o8 = (v2u*)dst + lane;
    if (!src) {
#pragma unroll
        for (int j = 0; j < 8; ++j) o8[64 * j] = (v2u){0u, 0u};
        return; }
    const f32x4* xr = (const f32x4*)src + lane; const f32x4* gr = (const f32x4*)gain + lane;
    f32x4 v[8], g[8]; float s = 0.f;
#pragma unroll
    for (int j = 0; j < 8; ++j) { v[j] = xr[64 * j]; g[j] = gr[64 * j]; }
#pragma unroll
    for (int j = 0; j < 8; ++j) s += (v[j].x * v[j].x + v[j].y * v[j].y) + (v[j].z * v[j].z + v[j].w * v[j].w);
    const float rs = 1.0f / sqrtf(wave_sum(s) * (1.0f / DM) + RMS_EPS);
#pragma unroll
    for (int j = 0; j < 8; ++j) o8[64 * j] = (v2u){pk2(v[j].x * rs * g[j].x, v[j].y * rs * g[j].y), pk2(v[j].z * rs * g[j].z, v[j].w * rs * g[j].w)};
}
template <int NC>
DI void gemv2_rows(const bf16* a0, const bf16* a1, const bf16* const (&brow)[NC], int lane, float (&o0)[NC], float (&o1)[NC]) {
    v4u xa[4], xb[4], w[NC][4];
#pragma unroll
    for (int i = 0; i < 4; ++i) { xa[i] = *(const v4u*)(a0 + lane * 8 + 512 * i); xb[i] = *(const v4u*)(a1 + lane * 8 + 512 * i); }
#pragma unroll
    for (int c = 0; c < NC; ++c)
#pragma unroll
        for (int i = 0; i < 4; ++i) w[c][i] = *(const v4u*)(brow[c] + lane * 8 + 512 * i);
#pragma unroll
    for (int c = 0; c < NC; ++c) {
        float s0 = 0.f, s1 = 0.f;
#pragma unroll
        for (int i = 0; i < 4; ++i) { float x0[8], x1[8], ww[8]; unpack8(xa[i], x0); unpack8(xb[i], x1); unpack8(w[c][i], ww);
#pragma unroll
            for (int e = 0; e < 8; ++e) { s0 += x0[e] * ww[e]; s1 += x1[e] * ww[e]; } }
        o0[c] = wave_sum(s0); o1[c] = wave_sum(s1);
    }
}
#define XB_TMO      128
#define XB_XCNT(j)  (256  + 64 * (j))
#define XB_XSUB(j)  (1280 + 64 * (j))
#define XB_XGEN(j)  (2304 + 64 * (j))
#define XB_TOP      3328
#define XB_TOPGEN   3392
#define XCD_BAR_WORDS 3456
#define XB_SPIN_CAP (1u << 18)

__device__ __forceinline__ unsigned xb_ld(unsigned* p)              { return __hip_atomic_load(p, __ATOMIC_RELAXED, __HIP_MEMORY_SCOPE_AGENT); }
__device__ __forceinline__ unsigned xb_add(unsigned* p, unsigned v) { return __hip_atomic_fetch_add(p, v, __ATOMIC_RELAXED, __HIP_MEMORY_SCOPE_AGENT); }
__device__ __forceinline__ unsigned xb_xcc_id() { return (unsigned)__builtin_amdgcn_s_getreg((3 << 11) | 20) & 0xFu; }
#define XB_SPIN(cond, bar) do { unsigned _sp = 0; while (cond) { __builtin_amdgcn_s_sleep(1); \
    if ((++_sp & 255u) == 0u) { if (xb_ld(&(bar)[XB_TMO])) break; if (_sp > XB_SPIN_CAP) { atomicAdd(&(bar)[XB_TMO], 1u); break; } } } } while (0)

struct XcdBarrier {
    unsigned* bar; unsigned x;
    volatile __attribute__((address_space(3))) unsigned* st;
};

__device__ __forceinline__ XcdBarrier xcd_barrier_post(unsigned* bar, volatile __attribute__((address_space(3))) unsigned* st) {
    XcdBarrier b; b.bar = bar; b.x = xb_xcc_id(); b.st = st;
    if (threadIdx.x == 0) (void)xb_add(&bar[XB_XCNT(b.x)], 1u);
    return b;
}
__device__ __forceinline__ void xcd_barrier_complete(unsigned* bar, unsigned x, unsigned& nloc, unsigned& nx) {
    const unsigned G = gridDim.x * gridDim.y * gridDim.z;
    unsigned sum, cnt, mine, sp = 0u;
    for (;;) {
        sum = 0u; cnt = 0u; mine = 0u;
#pragma unroll
        for (unsigned j = 0; j < 16; ++j) { const unsigned c = xb_ld(&bar[XB_XCNT(j)]); sum += c; cnt += (c > 0u) ? 1u : 0u; mine = (j == x) ? c : mine; }
        if (sum == G) break;
        __builtin_amdgcn_s_sleep(1);
        if ((++sp & 255u) == 0u) { if (xb_ld(&bar[XB_TMO])) break; if (sp > XB_SPIN_CAP) { atomicAdd(&bar[XB_TMO], 1u); break; } }
    }
    nloc = mine > 0u ? mine : 1u; nx = cnt > 0u ? cnt : 1u;
}

__device__ __forceinline__ void xcd_barrier(const XcdBarrier& b) {
    asm volatile("s_waitcnt vmcnt(0)" ::: "memory");
    __syncthreads();
    if (threadIdx.x == 0) {
        unsigned* bar = b.bar;
        __builtin_amdgcn_s_waitcnt(0);
        unsigned nloc = b.st[0], nx = b.st[1];
        if (nloc == 0u) { xcd_barrier_complete(bar, b.x, nloc, nx); b.st[0] = nloc; b.st[1] = nx; }
        const unsigned old = xb_add(&bar[XB_XSUB(b.x)], 1u);
        const unsigned gen = old / nloc;
        if (old + 1u == (gen + 1u) * nloc) {
            __builtin_amdgcn_fence(__ATOMIC_RELEASE, "agent");
            asm volatile("s_waitcnt vmcnt(0)" ::: "memory");
            const unsigned og = xb_add(&bar[XB_TOP], 1u);
            const unsigned tg = og / nx;
            if (og + 1u == (tg + 1u) * nx) xb_add(&bar[XB_TOPGEN], 1u);
            else XB_SPIN(xb_ld(&bar[XB_TOPGEN]) == tg, bar);
            __builtin_amdgcn_fence(__ATOMIC_ACQUIRE, "agent");
            xb_add(&bar[XB_XGEN(b.x)], 1u);
            asm volatile("s_waitcnt vmcnt(0)" ::: "memory");
        } else {
            XB_SPIN(xb_ld(&bar[XB_XGEN(b.x)]) == gen, bar);
            __builtin_amdgcn_fence(__ATOMIC_ACQUIRE, "agent");
            asm volatile("s_waitcnt vmcnt(0)" ::: "memory");
        }
    }
    __syncthreads();
}

DI void phase0(const Args& A, unsigned char* lds, int gw, int NGW, int wave, int lane) {
    unsigned char* ws = A.ws;
    float* scr = (float*)(lds + wave * 16640);
    bf16* WIN = (bf16*)(ws + WS_WIN); bf16* WOUT = (bf16*)(ws + WS_WOUT);
    constexpr int I_IN = (DM / 64) * (IN_COLS / 64), I_OUT = (DM / 64) * (DM / 64);
    for (int it = gw; it < I_IN + I_OUT; it += NGW) {
        if (it < I_IN) { const int kb = it / (IN_COLS / 64), nb = it % (IN_COLS / 64); tr_item(A.in[3], IN_COLS, WIN, DM, kb * 64, nb * 64, nb * 64, scr, lane); }
        else { const int r = it - I_IN, kb = r / (DM / 64), nb = r % (DM / 64); tr_item(A.in[16], DM, WOUT, DM, kb * 64, nb * 64, nb * 64, scr, lane); }
    }
    for (int i = gw * 64 + lane; i < (IN_PAD - IN_COLS) * DM / 8; i += NGW * 64) ((v4u*)(WIN + (size_t)IN_COLS * DM))[i] = (v4u){0u, 0u, 0u, 0u};
    { bf16* WL1 = (bf16*)(ws + WS_WL1); bf16* WL2 = (bf16*)(ws + WS_WL2);
#pragma unroll 4
      for (int i = gw * 64 + lane; i < 2048 * 256; i += NGW * 64) {
          const int n = i >> 8, k = i & 255, seg = n >> 10;
          const bool ok = seg == 0 ? (k < 96) : (k >= 128 && k < 224);
          const float* srcp = seg == 0 ? A.in[6] : A.in[8];
          const int kk = seg == 0 ? k : k - 128;
          const float v = srcp[ok ? kk * 1024 + (n & 1023) : 0];
          WL1[i] = ok ? (bf16)f2bf(v) : (bf16)0;
      }
#pragma unroll 4
      for (int i = gw * 64 + lane; i < 1024 * 256; i += NGW * 64) { const int n = i >> 8, k = i & 255; WL2[i] = (bf16)f2bf(A.in[10][k * 1024 + n]); }
    }
    bf16* XN = (bf16*)(ws + WS_BUFA);
    for (int m = gw; m < MP; m += NGW) {
        const float* src = m < MX ? A.in[0] + (size_t)m * DM : (m < MROWS ? A.in[1] + (size_t)(m - MX) * DM : nullptr);
        rms_row_bf16(src, A.in[2], XN + (size_t)m * DM, lane);
    }
}
DI void convert_late(const Args& A, unsigned char* lds, int cw, int NCW, int wave, int lane) {
    unsigned char* ws = A.ws; float* scr = (float*)(lds + wave * 16640);
    bf16* WGU = (bf16*)(ws + WS_WGU); bf16* WDN = (bf16*)(ws + WS_WDN);
    constexpr int I_GU = (DM / 64) * (2 * DFF / 64), I_DN = (DFF / 64) * (DM / 64);
    for (int it = cw; it < I_GU + I_DN; it += NCW) {
        if (it < I_GU) { const int kb = it / (2 * DFF / 64), nb = it % (2 * DFF / 64); const int n0 = nb * 64; const int j = n0 < DFF ? n0 : n0 - DFF;
            const int drow = 256 * (j >> 7) + (n0 < DFF ? 0 : 128) + (j & 127);
            tr_item(A.in[19], 2 * DFF, WGU, DM, kb * 64, n0, drow, scr, lane); }
        else { const int r = it - I_GU, kb = r / (DM / 64), nb = r % (DM / 64); tr_item(A.in[21], DM, WDN, DFF, kb * 64, nb * 64, nb * 64, scr, lane); }
    }
}
DI void phase2a(const Args& A, int gw, int NGW, int lane) {
    unsigned char* ws = A.ws;
    const bf16* ZC = (const bf16*)(ws + WS_ZC); const bf16* ZR = (const bf16*)(ws + WS_ZR); bf16* YA = (bf16*)(ws + WS_BUFA); bf16* LA = (bf16*)(ws + WS_LA);
    const float* cwp = A.in[4]; const float* mu = A.in[5];
    float w0[16], w1[16], w2[16];
#pragma unroll
    for (int e4 = 0; e4 < 4; ++e4) { const f32x4 a = *(const f32x4*)(cwp + lane * 16 + 4 * e4), b = *(const f32x4*)(cwp + 1024 + lane * 16 + 4 * e4), c = *(const f32x4*)(cwp + 2048 + lane * 16 + 4 * e4);
#pragma unroll
        for (int x = 0; x < 4; ++x) { w0[4 * e4 + x] = a[x]; w1[4 * e4 + x] = b[x]; w2[4 * e4 + x] = c[x]; } }
    int src = 0, kind = 0;
    if (lane < 12) { src = 3072 + 8 * lane; kind = 1; } else if (lane >= 16 && lane < 28) { src = 3168 + 8 * (lane - 16); kind = 2; } else if (lane >= 32) { src = 3264 + 8 * (lane - 32); kind = 3; }
    float mus[8];
    { const f32x4 a = *(const f32x4*)(mu + src), b = *(const f32x4*)(mu + src + 4); mus[0] = a.x; mus[1] = a.y; mus[2] = a.z; mus[3] = a.w; mus[4] = b.x; mus[5] = b.y; mus[6] = b.z; mus[7] = b.w; }
    for (int grp = gw; grp < MROWS / 4; grp += NGW) {
        const int t0 = grp * 4;
        const int p1 = prev_row(t0), p2 = p1 >= 0 ? prev_row(p1) : -1;
        const int q1 = p1 >= 0 ? p1 : t0, q2 = p2 >= 0 ? p2 : t0;
        const float f1 = p1 >= 0 ? 1.f : 0.f, f2 = p2 >= 0 ? 1.f : 0.f;
        v4u lz[5];
        lz[0] = *(const v4u*)(ZR + (size_t)q1 * ZR_LD + src);
#pragma unroll
        for (int r = 0; r < 4; ++r) lz[1 + r] = *(const v4u*)(ZR + (size_t)(t0 + r) * ZR_LD + src);
#pragma unroll
        for (int hv = 0; hv < 2; ++hv) {
            const int c8 = lane * 16 + hv * 8;
            v4u lc[6], lh[6], lb[4];
            { const bf16* za = ZC + (size_t)q2 * ZC_LD + c8; const bf16* zb = ZC + (size_t)q1 * ZC_LD + c8;
              lc[0] = *(const v4u*)(za + 1024); lh[0] = *(const v4u*)(za + 2048); lc[1] = *(const v4u*)(zb + 1024); lh[1] = *(const v4u*)(zb + 2048); }
#pragma unroll
            for (int r = 0; r < 4; ++r) { const bf16* z0 = ZC + (size_t)(t0 + r) * ZC_LD + c8; lb[r] = *(const v4u*)z0; lc[2 + r] = *(const v4u*)(z0 + 1024); lh[2 + r] = *(const v4u*)(z0 + 2048); }
            float pr[6][8];
#pragma unroll
            for (int r = 0; r < 6; ++r) { float cc[8], hh[8]; unpack8(lc[r], cc); unpack8(lh[r], hh); const float fl = r == 0 ? f2 : (r == 1 ? f1 : 1.f);
#pragma unroll
                for (int e = 0; e < 8; ++e) pr[r][e] = fl * cc[e] * hh[e]; }
#pragma unroll
            for (int r = 0; r < 4; ++r) { float bv[8], o[8]; unpack8(lb[r], bv);
#pragma unroll
                for (int e = 0; e < 8; ++e) o[e] = bv[e] * (w0[hv * 8 + e] * pr[r][e] + w1[hv * 8 + e] * pr[r + 1][e] + w2[hv * 8 + e] * pr[r + 2][e]);
                *(v4u*)(YA + (size_t)(t0 + r) * DM + c8) = pack8(o); }
        }
#pragma unroll
        for (int r = 0; r < 4; ++r) {
            v4u outw = (v4u){0u, 0u, 0u, 0u};
            if (kind != 0) {
                float z[8], zp[8], o[8]; unpack8(lz[1 + r], z); unpack8(lz[r], zp); const float fp = r == 0 ? f1 : 1.f;
#pragma unroll
                for (int e = 0; e < 8; ++e) { const float sv = z[e] + (fp * zp[e] - z[e]) * mus[e];
                    const float th = 1.0f - 2.0f * __builtin_amdgcn_rcpf(1.0f + __expf(2.0f * sv));
                    o[e] = kind == 1 ? th : (kind == 2 ? sv : sigmoidf_(sv)); }
                outw = pack8(o);
            }
            const int t = t0 + r;
            *(v4u*)(lane < 32 ? LA + (size_t)t * 256 + 8 * lane : LA + (size_t)MP * 256 + (size_t)t * 256 + 8 * (lane - 32)) = outw;
        }
    }
}
constexpr int LP = 144;
constexpr int L_AT = 0, L_BT = 9216, L_KT = 18432, L_RT = 27648, L_BHT = 36864, L_KHT = 46080, L_VT = 55296, L_AAK = 64512, L_ARB = 73728, L_ARK = 82944, L_AAB = 92160;
constexpr int L_WT = 101376;
constexpr int L_GC = 103424;
constexpr int L_TD = 103680;
constexpr int L_PAR = 105728;
constexpr int L_XT = L_BT;
constexpr int L_SQ = L_AT, L_SM = L_BT, L_SN = L_KT, L_SY = L_RT;
static_assert(L_PAR + 2048 <= 131072, "lds");
#define MFMA16(a, b, c) __builtin_amdgcn_mfma_f32_16x16x32_bf16((a), (b), (c), 0, 0, 0)
DI bf16x8 ldfrag(const unsigned char* base, int row, int s, int q) { return *(const bf16x8*)(base + row * LP + (s * 32 + q * 8) * 2); }
DI bf16x8 ldfrag_sw(const unsigned char* base, int row, int s, int q) { return *(const bf16x8*)(base + row * LP + (((s * 4 + q) ^ ((row >> 3) & 7)) * 16)); }
DI void st_bf(unsigned char* base, int row, int col, float v) { *(bf16*)(base + row * LP + col * 2) = (bf16)f2bf(v); }
DI bf16x8 half_frag(v2u lo) { v4u w; w.x = lo.x; w.y = lo.y; w.z = 0u; w.w = 0u; return __builtin_bit_cast(bf16x8, w); }

struct C1Raw { v4u z[3], zp[3], dec, aa; };
DI void c1_rows(int b, int c, int i, int& pos, bool& valid, int& row, int& prow) {
    pos = c * 64 + i; valid = pos < LSEQ;
    row = valid ? (pos < NMETA ? MX + pos : b * SEQ + pos - NMETA) : 0; prow = prev_row(row);
}
DI void c1_load(C1Raw& R, const bf16* ZR, const bf16* LODA, int b, int c, int i, int col) {
    int pos, row, prow; bool valid; c1_rows(b, c, i, pos, valid, row, prow);
    const bf16* zr = ZR + (size_t)row * ZR_LD + col; const bf16* zpr = ZR + (size_t)(prow >= 0 ? prow : 0) * ZR_LD + col;
#pragma unroll
    for (int p = 0; p < 3; ++p) { R.z[p] = *(const v4u*)(zr + p * 1024); R.zp[p] = *(const v4u*)(zpr + p * 1024); }
    R.dec = *(const v4u*)(LODA + (size_t)row * 2048 + col); R.aa = *(const v4u*)(LODA + (size_t)row * 2048 + 1024 + col);
}

DI void phase_c1(const Args& A, unsigned char* lds_, int bx, int G, int tid, int wave, int lane) {
    unsigned char* ws = A.ws;
    const bf16* ZR = (const bf16*)(ws + WS_ZR); const bf16* LODA = (const bf16*)(ws + WS_LODA);
    float* BON = (float*)(ws + WS_BON);
    const int r16 = lane & 15, q = lane >> 4;
    const int tm = wave >> 1, tn0 = (wave & 1) * 2;
    const int h = bx & 15, NBC = NBATCH * NCH, bc0 = bx >> 4, bcs = G >> 4;
    const int i = tid >> 3, cgp = tid & 7, c0 = cgp * 8, col = h * 64 + c0;
    { float* PAR = (float*)(lds_ + L_PAR); const int pa = tid >> 6, ch = tid & 63; const float* src = pa < 3 ? A.in[5] + pa * 1024 : (pa == 3 ? A.in[7] : pa == 4 ? A.in[9] : pa == 5 ? A.in[11] : pa == 6 ? A.in[12] : A.in[13]);
      PAR[pa * 64 + ch] = src[h * 64 + ch]; }
    __syncthreads();
    if (bc0 >= NBC) return;
    C1Raw cur; c1_load(cur, ZR, LODA, bc0 / NCH, bc0 % NCH, i, col);
    for (int bc = bc0; bc < NBC; bc += bcs) {
        int oz = 0; asm volatile("" : "+s"(oz));
        unsigned char* L = lds_ + oz; float* WT = (float*)(L + L_WT); float* GC = (float*)(L + L_GC); const float* PAR = (const float*)(L + L_PAR);
        const int c = bc % NCH, b = bc / NCH, item = bc * 16 + h;
        int pos, row, prow; bool valid; c1_rows(b, c, i, pos, valid, row, prow);
        float rr[8], vr[8], lw[8], av[8], bv[8], kp[8];
        {
            float mur[8], muk[8], muv[8], w0v[8], a0v[8], kkv[8], kav[8], rkv[8];
#pragma unroll
            for (int e = 0; e < 8; ++e) { mur[e] = PAR[c0 + e]; muk[e] = PAR[64 + c0 + e]; muv[e] = PAR[128 + c0 + e]; w0v[e] = PAR[192 + c0 + e]; a0v[e] = PAR[256 + c0 + e];
                kkv[e] = PAR[320 + c0 + e]; kav[e] = PAR[384 + c0 + e]; rkv[e] = PAR[448 + c0 + e]; }
            float kr[8], z[8], zp[8];
            unpack8(cur.z[0], z); unpack8(cur.zp[0], zp);
#pragma unroll
            for (int e = 0; e < 8; ++e) { const float zq = prow >= 0 ? zp[e] : 0.f; rr[e] = z[e] + (zq - z[e]) * mur[e]; }
            unpack8(cur.z[1], z); unpack8(cur.zp[1], zp);
#pragma unroll
            for (int e = 0; e < 8; ++e) { const float zq = prow >= 0 ? zp[e] : 0.f; kr[e] = z[e] + (zq - z[e]) * muk[e]; }
            unpack8(cur.z[2], z); unpack8(cur.zp[2], zp);
#pragma unroll
            for (int e = 0; e < 8; ++e) { const float zq = prow >= 0 ? zp[e] : 0.f; vr[e] = z[e] + (zq - z[e]) * muv[e]; }
            float dec[8], aa[8]; unpack8(cur.dec, dec); unpack8(cur.aa, aa);
            { const int bn = bc + bcs; if (bn < NBC) c1_load(cur, ZR, LODA, bn / NCH, bn % NCH, i, col); }
            float ss = 0.f, bon = 0.f, as[8], kk[8];
#pragma unroll
            for (int e = 0; e < 8; ++e) {
                lw[e] = -DECAY_SCALE * sigmoidf_(w0v[e] + dec[e]);
                as[e] = sigmoidf_(a0v[e] + aa[e]);
                kk[e] = kr[e] * kkv[e]; ss += kk[e] * kk[e];
                kp[e] = kr[e] * (1.0f + (as[e] - 1.0f) * kav[e]);
                bon += rr[e] * kp[e] * rkv[e];
            }
            ss += __shfl_xor(ss, 1); ss += __shfl_xor(ss, 2); ss += __shfl_xor(ss, 4);
            bon += __shfl_xor(bon, 1); bon += __shfl_xor(bon, 2); bon += __shfl_xor(bon, 4);
            const float inv = __builtin_amdgcn_rcpf(fmaxf(__builtin_amdgcn_sqrtf(ss), 1e-12f));
#pragma unroll
            for (int e = 0; e < 8; ++e) { const float kn = kk[e] * inv; av[e] = -kn; bv[e] = kn * as[e]; }
            if (!valid) {
#pragma unroll
                for (int e = 0; e < 8; ++e) { lw[e] = 0.f; rr[e] = 0.f; kp[e] = 0.f; vr[e] = 0.f; av[e] = 0.f; bv[e] = 0.f; } }
            if (cgp == 0 && valid) BON[((size_t)b * (NCH * 64) + pos) * NHEAD + h] = bon;
        }
        float Lc[8];
#pragma unroll
        for (int e = 0; e < 8; ++e) { float v = lw[e];
            float t = __shfl_up(v, 8); if (lane >= 8) v += t;
            t = __shfl_up(v, 16); if (lane >= 16) v += t;
            t = __shfl_up(v, 32); if (lane >= 32) v += t;
            Lc[e] = v; }
        if (lane >= 56) { *(f32x4*)(WT + wave * 64 + c0) = (f32x4){Lc[0], Lc[1], Lc[2], Lc[3]}; *(f32x4*)(WT + wave * 64 + c0 + 4) = (f32x4){Lc[4], Lc[5], Lc[6], Lc[7]}; }
        __syncthreads();
        {
            float pre[8], tot[8];
#pragma unroll
            for (int e = 0; e < 8; ++e) { pre[e] = 0.f; tot[e] = 0.f; }
#pragma unroll
            for (int g = 0; g < 8; ++g) { const f32x4 t0 = *(const f32x4*)(WT + g * 64 + c0), t1 = *(const f32x4*)(WT + g * 64 + c0 + 4);
                const float tv[8] = {t0.x, t0.y, t0.z, t0.w, t1.x, t1.y, t1.z, t1.w};
#pragma unroll
                for (int e = 0; e < 8; ++e) { tot[e] += tv[e]; if (g < wave) pre[e] += tv[e]; } }
            float at[8], rt[8], bt[8], kt[8];
            const int swb = ((wave ^ cgp) * 16) + (i & 7) * 2;
#pragma unroll
            for (int e = 0; e < 8; ++e) {
                const float Lv = Lc[e] + pre[e], Lt = tot[e];
                const float eL = __expf(Lv), eLex = __expf(Lv - lw[e]), einv = __expf(-Lv), eh = __expf(Lt - Lv);
                at[e] = av[e] * eLex; rt[e] = rr[e] * eL; bt[e] = bv[e] * einv; kt[e] = kp[e] * einv;
                *(bf16*)(L + L_BHT + (c0 + e) * LP + swb) = (bf16)f2bf(bv[e] * eh);
                *(bf16*)(L + L_KHT + (c0 + e) * LP + swb) = (bf16)f2bf(kp[e] * eh);
                *(bf16*)(L + L_VT + (c0 + e) * LP + swb) = (bf16)f2bf(vr[e]);
                if (i == 63) GC[c0 + e] = eL;
            }
            *(v4u*)(L + L_AT + i * LP + c0 * 2) = pack8(at); *(v4u*)(L + L_RT + i * LP + c0 * 2) = pack8(rt);
            *(v4u*)(L + L_BT + i * LP + c0 * 2) = pack8(bt); *(v4u*)(L + L_KT + i * LP + c0 * 2) = pack8(kt);
        }
        __syncthreads();
        {
            f32x4 aab[2], aak[2], arb[2], ark[2];
#pragma unroll
            for (int t = 0; t < 2; ++t) { aab[t] = (f32x4){0.f, 0.f, 0.f, 0.f}; aak[t] = aab[t]; arb[t] = aab[t]; ark[t] = aab[t]; }
#pragma unroll
            for (int s = 0; s < 2; ++s) {
                const bf16x8 fa = ldfrag(L + L_AT, tm * 16 + r16, s, q), fr_ = ldfrag(L + L_RT, tm * 16 + r16, s, q);
#pragma unroll
                for (int t = 0; t < 2; ++t) {
                    const bf16x8 fb = ldfrag(L + L_BT, (tn0 + t) * 16 + r16, s, q), fk = ldfrag(L + L_KT, (tn0 + t) * 16 + r16, s, q);
                    aab[t] = MFMA16(fa, fb, aab[t]); aak[t] = MFMA16(fa, fk, aak[t]); arb[t] = MFMA16(fr_, fb, arb[t]); ark[t] = MFMA16(fr_, fk, ark[t]);
                }
            }
#pragma unroll
            for (int t = 0; t < 2; ++t)
#pragma unroll
                for (int jj = 0; jj < 4; ++jj) {
                    const int ri = tm * 16 + 4 * q + jj, cj = (tn0 + t) * 16 + r16;
                    st_bf(L + L_AAB, ri, cj, cj < ri ? aab[t][jj] : 0.f);
                    st_bf(L + L_AAK, ri, cj, cj < ri ? aak[t][jj] : 0.f);
                    st_bf(L + L_ARB, ri, cj, cj <= ri ? arb[t][jj] : 0.f);
                    st_bf(L + L_ARK, ri, cj, cj <= ri ? ark[t][jj] : 0.f);
                }
        }
        __syncthreads();
        if (wave == 0) {
            const int db = lane >> 4, dj = lane & 15; float x[16];
#pragma unroll
            for (int hf = 0; hf < 2; ++hf) {
                v4u ra[8][2];
#pragma unroll
                for (int r8 = 0; r8 < 8; ++r8) { const int r = hf * 8 + r8;
                    ra[r8][0] = *(const v4u*)(L + L_AAB + (16 * db + r) * LP + (16 * db) * 2); ra[r8][1] = *(const v4u*)(L + L_AAB + (16 * db + r) * LP + (16 * db + 8) * 2); }
#pragma unroll
                for (int r8 = 0; r8 < 8; ++r8) { const int r = hf * 8 + r8;
                    float a[16]; float t0[8], t1[8]; unpack8(ra[r8][0], t0); unpack8(ra[r8][1], t1);
#pragma unroll
                    for (int e = 0; e < 8; ++e) { a[e] = t0[e]; a[8 + e] = t1[e]; }
                    float acc = (r == dj) ? 1.0f : 0.f;
#pragma unroll
                    for (int k = 0; k < 16; ++k) if (k < r) acc = fmaf(a[k], x[k], acc);
                    x[r] = acc; }
                asm volatile("" ::: "memory");
            }
#pragma unroll
            for (int r = 0; r < 16; ++r) *(bf16*)(L + L_TD + db * 512 + r * 32 + dj * 2) = (bf16)f2bf(x[r]);
        }
        f32x4 y1a[2], nna[2], Rs[4];
        {
#pragma unroll
            for (int t = 0; t < 2; ++t) { y1a[t] = (f32x4){0.f, 0.f, 0.f, 0.f}; nna[t] = y1a[t]; }
#pragma unroll
            for (int s = 0; s < 2; ++s) {
                const bf16x8 frk = ldfrag(L + L_ARK, tm * 16 + r16, s, q), fkh = ldfrag_sw(L + L_KHT, tm * 16 + r16, s, q);
#pragma unroll
                for (int t = 0; t < 2; ++t) {
                    const bf16x8 fv = ldfrag_sw(L + L_VT, (tn0 + t) * 16 + r16, s, q);
                    y1a[t] = MFMA16(frk, fv, y1a[t]); nna[t] = MFMA16(fkh, fv, nna[t]);
                }
            }
            if (wave < 4) {
#pragma unroll
                for (int bb = 0; bb < 4; ++bb)
#pragma unroll
                    for (int jj = 0; jj < 4; ++jj) Rs[bb][jj] = bf2f(*(const bf16*)(L + L_AT + (16 * bb + 4 * q + jj) * LP + (16 * wave + r16) * 2));
            } else {
#pragma unroll
                for (int bb = 0; bb < 4; ++bb) Rs[bb] = (f32x4){0.f, 0.f, 0.f, 0.f};
#pragma unroll
                for (int s = 0; s < 2; ++s) {
                    const bf16x8 fv = ldfrag_sw(L + L_VT, (wave - 4) * 16 + r16, s, q);
#pragma unroll
                    for (int bb = 0; bb < 4; ++bb) Rs[bb] = MFMA16(ldfrag(L + L_AAK, 16 * bb + r16, s, q), fv, Rs[bb]);
                }
            }
        }
        __syncthreads();
        {
            bf16x8 xb[4];
#pragma unroll
            for (int bb = 0; bb < 4; ++bb) {
                f32x4 acc = Rs[bb];
#pragma unroll
                for (int bp = 0; bp < 4; ++bp) if (bp < bb) acc = MFMA16(half_frag(*(const v2u*)(L + L_AAB + (16 * bb + r16) * LP + (16 * bp + 4 * q) * 2)), xb[bp], acc);
                v2u pb; pb.x = pk2(acc[0], acc[1]); pb.y = pk2(acc[2], acc[3]);
                const f32x4 xa = MFMA16(half_frag(*(const v2u*)(L + L_TD + bb * 512 + r16 * 32 + 4 * q * 2)), half_frag(pb), ((f32x4){0.f, 0.f, 0.f, 0.f}));
                v2u px; px.x = pk2(xa[0], xa[1]); px.y = pk2(xa[2], xa[3]);
                xb[bb] = half_frag(px);
                *(v2u*)(L + L_XT + (16 * wave + r16) * LP + (16 * bb + 4 * q) * 2) = px;
            }
        }
        __syncthreads();
        f32x4 qa[2], ma[2];
        {
#pragma unroll
            for (int t = 0; t < 2; ++t) { qa[t] = (f32x4){0.f, 0.f, 0.f, 0.f}; ma[t] = qa[t]; }
#pragma unroll
            for (int s = 0; s < 2; ++s) {
                const bf16x8 frb = ldfrag(L + L_ARB, tm * 16 + r16, s, q), fbh = ldfrag_sw(L + L_BHT, tm * 16 + r16, s, q);
#pragma unroll
                for (int t = 0; t < 2; ++t) {
                    const bf16x8 fw = ldfrag(L + L_XT, (tn0 + t) * 16 + r16, s, q), fu = ldfrag(L + L_XT, 64 + (tn0 + t) * 16 + r16, s, q);
                    qa[t] = MFMA16(frb, fw, qa[t]); y1a[t] = MFMA16(frb, fu, y1a[t]); ma[t] = MFMA16(fbh, fw, ma[t]); nna[t] = MFMA16(fbh, fu, nna[t]);
                }
            }
#pragma unroll
            for (int t = 0; t < 2; ++t)
#pragma unroll
                for (int jj = 0; jj < 4; ++jj) {
                    const int ri = tm * 16 + 4 * q + jj, cj = (tn0 + t) * 16 + r16;
                    qa[t][jj] += bf2f(*(const bf16*)(L + L_RT + ri * LP + cj * 2));
                    if (ri == cj) ma[t][jj] += GC[ri];
                }
        }
        __syncthreads();
#pragma unroll
        for (int t = 0; t < 2; ++t)
#pragma unroll
            for (int jj = 0; jj < 4; ++jj) {
                const int ri = tm * 16 + 4 * q + jj, cj = (tn0 + t) * 16 + r16;
                st_bf(L + L_SQ, ri, cj, qa[t][jj]); st_bf(L + L_SM, ri, cj, ma[t][jj]); st_bf(L + L_SN, ri, cj, nna[t][jj]); st_bf(L + L_SY, ri, cj, y1a[t][jj]);
            }
        __syncthreads();
        {
            const int fi = tid >> 6, mt = fi >> 1, s = fi & 1; const int srow = 16 * mt + r16;
            const v2u q0 = *(const v2u*)(L + L_SQ + srow * LP + (32 * s + 4 * q) * 2), q1 = *(const v2u*)(L + L_SQ + srow * LP + (32 * s + 16 + 4 * q) * 2);
            const v2u m0 = *(const v2u*)(L + L_SM + srow * LP + (32 * s + 4 * q) * 2), m1 = *(const v2u*)(L + L_SM + srow * LP + (32 * s + 16 + 4 * q) * 2);
            *(v4u*)(ws + WS_QF + (size_t)item * 8192 + tid * 16) = (v4u){q0.x, q0.y, q1.x, q1.y};
            *(v4u*)(ws + WS_MF + (size_t)item * 8192 + tid * 16) = (v4u){m0.x, m0.y, m1.x, m1.y};
            const int g4 = (tid >> 6) & 3; float o[16];
            if (tid < 256) {
#pragma unroll
                for (int m2 = 0; m2 < 4; ++m2)
#pragma unroll
                    for (int jj = 0; jj < 4; ++jj) o[m2 * 4 + jj] = bf2f(*(const bf16*)(L + L_SN + (16 * m2 + 4 * q + jj) * LP + (16 * g4 + r16) * 2));
            } else {
#pragma unroll
                for (int v2 = 0; v2 < 4; ++v2)
#pragma unroll
                    for (int jj = 0; jj < 4; ++jj) o[v2 * 4 + jj] = bf2f(*(const bf16*)(L + L_SY + (16 * g4 + 4 * q + jj) * LP + (16 * v2 + r16) * 2));
            }
            v4u w0, w1; w0.x = pk2(o[0], o[1]); w0.y = pk2(o[2], o[3]); w0.z = pk2(o[4], o[5]); w0.w = pk2(o[6], o[7]); w1.x = pk2(o[8], o[9]); w1.y = pk2(o[10], o[11]); w1.z = pk2(o[12], o[13]); w1.w = pk2(o[14], o[15]);
            unsigned char* dst = ws + (tid < 256 ? WS_NB : WS_Y1) + (size_t)item * 8192 + (size_t)(g4 * 64 + lane) * 32;
            *(v4u*)dst = w0; *(v4u*)(dst + 16) = w1;
        }
        __syncthreads();
    }
}
struct C2Stage { v4u mf[4][2]; v4u nb0, nb1; };
DI void c2_load(C2Stage& st, const unsigned char* ws, int b, int h, int vs, int lane, int cc) {
    const int cl = cc < NCH ? cc : NCH - 1; const size_t item = (size_t)(b * NCH + cl) * 16 + h;
#pragma unroll
    for (int m = 0; m < 4; ++m)
#pragma unroll
        for (int s = 0; s < 2; ++s) st.mf[m][s] = *(const v4u*)(ws + WS_MF + item * 8192 + (size_t)((m * 2 + s) * 64 + lane) * 16);
    st.nb0 = *(const v4u*)(ws + WS_NB + item * 8192 + (size_t)(vs * 64 + lane) * 32); st.nb1 = *(const v4u*)(ws + WS_NB + item * 8192 + (size_t)(vs * 64 + lane) * 32 + 16);
}
DI void c2_step(const C2Stage& st, f32x4 (&Hs)[4], unsigned char* ws, int b, int h, int vs, int lane, int cc) {
    if (cc >= NCH) return;
    const size_t item = (size_t)(b * NCH + cc) * 16 + h;
    v4u hw[2];
#pragma unroll
    for (int s = 0; s < 2; ++s) { hw[s].x = pk2(Hs[2 * s][0], Hs[2 * s][1]); hw[s].y = pk2(Hs[2 * s][2], Hs[2 * s][3]); hw[s].z = pk2(Hs[2 * s + 1][0], Hs[2 * s + 1][1]); hw[s].w = pk2(Hs[2 * s + 1][2], Hs[2 * s + 1][3]);
        *(v4u*)(ws + WS_HST + item * 8192 + (size_t)((vs * 2 + s) * 64 + lane) * 16) = hw[s]; }
    float nf[16]; { float t0[8], t1[8]; unpack8(st.nb0, t0); unpack8(st.nb1, t1);
#pragma unroll
        for (int e = 0; e < 8; ++e) { nf[e] = t0[e]; nf[8 + e] = t1[e]; } }
#pragma unroll
    for (int m = 0; m < 4; ++m) {
        f32x4 acc = (f32x4){nf[m * 4], nf[m * 4 + 1], nf[m * 4 + 2], nf[m * 4 + 3]};
#pragma unroll
        for (int s = 0; s < 2; ++s) acc = MFMA16(__builtin_bit_cast(bf16x8, st.mf[m][s]), __builtin_bit_cast(bf16x8, hw[s]), acc);
        Hs[m] = acc;
    }
}
DI void phase_c2(const Args& A, int bh, int vs, int lane) {
    unsigned char* ws = A.ws;
    const int b = bh >> 4, h = bh & 15;
    f32x4 Hs[4];
#pragma unroll
    for (int m = 0; m < 4; ++m) Hs[m] = (f32x4){0.f, 0.f, 0.f, 0.f};
    C2Stage s0, s1, s2, s3, s4;
    c2_load(s0, ws, b, h, vs, lane, 0); c2_load(s1, ws, b, h, vs, lane, 1); c2_load(s2, ws, b, h, vs, lane, 2); c2_load(s3, ws, b, h, vs, lane, 3);
#pragma unroll
    for (int c = 0; c < NCH; c += 5) {
        c2_load(s4, ws, b, h, vs, lane, c + 4); c2_step(s0, Hs, ws, b, h, vs, lane, c);
        c2_load(s0, ws, b, h, vs, lane, c + 5); c2_step(s1, Hs, ws, b, h, vs, lane, c + 1);
        c2_load(s1, ws, b, h, vs, lane, c + 6); c2_step(s2, Hs, ws, b, h, vs, lane, c + 2);
        c2_load(s2, ws, b, h, vs, lane, c + 7); c2_step(s3, Hs, ws, b, h, vs, lane, c + 3);
        c2_load(s3, ws, b, h, vs, lane, c + 8); c2_step(s4, Hs, ws, b, h, vs, lane, c + 4);
    }
}
DI void phase_c3(const Args& A, int bx, int G, int wave, int lane) {
    unsigned char* ws = A.ws;
    const bf16* ZR = (const bf16*)(ws + WS_ZR); const bf16* LOG = (const bf16*)(ws + WS_LOG); const float* BON = (const float*)(ws + WS_BON); bf16* YA = (bf16*)(ws + WS_BUFA);
    const float* mu = A.in[5]; const float* lnw = A.in[14]; const float* lnb = A.in[15];
    const int half = wave >> 2, mt = wave & 3, n = lane & 15, q = lane >> 4;
    for (int item = bx * 2 + half; item < NITEM; item += 2 * G) {
        const int h = item & 15, bc = item >> 4, c = bc % NCH, b = bc / NCH;
        f32x4 acc[4];
        {
            const v4u y0 = *(const v4u*)(ws + WS_Y1 + (size_t)item * 8192 + (size_t)(mt * 64 + lane) * 32), y1 = *(const v4u*)(ws + WS_Y1 + (size_t)item * 8192 + (size_t)(mt * 64 + lane) * 32 + 16);
            float t0[8], t1[8]; unpack8(y0, t0); unpack8(y1, t1);
            acc[0] = (f32x4){t0[0], t0[1], t0[2], t0[3]}; acc[1] = (f32x4){t0[4], t0[5], t0[6], t0[7]}; acc[2] = (f32x4){t1[0], t1[1], t1[2], t1[3]}; acc[3] = (f32x4){t1[4], t1[5], t1[6], t1[7]};
        }
#pragma unroll
        for (int s = 0; s < 2; ++s) {
            const v4u qf = *(const v4u*)(ws + WS_QF + (size_t)item * 8192 + (size_t)((mt * 2 + s) * 64 + lane) * 16);
#pragma unroll
            for (int vs = 0; vs < 4; ++vs) {
                const v4u hf = *(const v4u*)(ws + WS_HST + (size_t)item * 8192 + (size_t)((vs * 2 + s) * 64 + lane) * 16);
                acc[vs] = MFMA16(__builtin_bit_cast(bf16x8, qf), __builtin_bit_cast(bf16x8, hf), acc[vs]);
            }
        }
        float lw_[4], lb_[4], mv_[4];
#pragma unroll
        for (int vs = 0; vs < 4; ++vs) { const int col = h * 64 + vs * 16 + n; lw_[vs] = lnw[col]; lb_[vs] = lnb[col]; mv_[vs] = mu[2048 + col]; }
        unsigned vv_[4][4], vp_[4][4], gg_[4][4]; float bon_[4]; int row_[4]; bool ok_[4], hp_[4];
#pragma unroll
        for (int jj = 0; jj < 4; ++jj) {
            const int i = 16 * mt + 4 * q + jj, pos = c * 64 + i;
            ok_[jj] = pos < LSEQ && (pos >= NMETA || b == 0);
            const int posc = pos < LSEQ ? pos : LSEQ - 1;
            const int row = posc < NMETA ? MX + posc : b * SEQ + posc - NMETA, prow = prev_row(row);
            row_[jj] = row; hp_[jj] = prow >= 0;
            const int prc = prow >= 0 ? prow : row;
            bon_[jj] = BON[((size_t)b * (NCH * 64) + posc) * NHEAD + h];
#pragma unroll
            for (int vs = 0; vs < 4; ++vs) {
                const int col = h * 64 + vs * 16 + n;
                vv_[jj][vs] = (unsigned)ZR[(size_t)row * ZR_LD + 2048 + col];
                vp_[jj][vs] = (unsigned)ZR[(size_t)prc * ZR_LD + 2048 + col];
                gg_[jj][vs] = (unsigned)LOG[(size_t)row * 1024 + col];
            }
        }
#pragma unroll
        for (int jj = 0; jj < 4; ++jj) {
            float s1 = (acc[0][jj] + acc[1][jj]) + (acc[2][jj] + acc[3][jj]);
            s1 += __shfl_xor(s1, 1); s1 += __shfl_xor(s1, 2); s1 += __shfl_xor(s1, 4); s1 += __shfl_xor(s1, 8);
            const float mean = s1 * (1.0f / 64.0f);
            float d[4], s2 = 0.f;
#pragma unroll
            for (int vs = 0; vs < 4; ++vs) { d[vs] = acc[vs][jj] - mean; s2 += d[vs] * d[vs]; }
            s2 += __shfl_xor(s2, 1); s2 += __shfl_xor(s2, 2); s2 += __shfl_xor(s2, 4); s2 += __shfl_xor(s2, 8);
            const float rstd = __builtin_amdgcn_rsqf(s2 * (1.0f / 64.0f) + GN_EPS);
            if (ok_[jj]) {
#pragma unroll
                for (int vs = 0; vs < 4; ++vs) {
                    const int col = h * 64 + vs * 16 + n;
                    const float vv = bflo(vv_[jj][vs]), vp = hp_[jj] ? bflo(vp_[jj][vs]) : 0.f;
                    const float vsh = vv + (vp - vv) * mv_[vs];
                    const float y = (d[vs] * rstd * lw_[vs] + lb_[vs] + bon_[jj] * vsh) * bflo(gg_[jj][vs]);
                    YA[(size_t)row_[jj] * DM + 1024 + col] = (bf16)f2bf(y);
                }
            }
        }
    }
}
DI void phase4(const Args& A, int gw, int NGW, int lane) {
    unsigned char* ws = A.ws;
    const bf16* MIX = (const bf16*)(ws + WS_MIX); const float* MIXM = (const float*)(ws + WS_MIXM); bf16* N2 = (bf16*)(ws + WS_BUFA); bf16* N2M = (bf16*)(ws + WS_N2M);
    const f32x4* g1 = (const f32x4*)A.in[17] + lane; const f32x4* g2 = (const f32x4*)A.in[18] + lane;
    for (int m = gw; m < MX + 2; m += NGW) {
        const f32x4* hr = (const f32x4*)(m < MX ? A.in[0] + (size_t)m * DM : A.in[1] + (size_t)(14 + m - MX) * DM) + lane;
        f32x4 v[8], hh[8], ga[8], gb[8]; float s = 0.f;
#pragma unroll
        for (int j = 0; j < 8; ++j) { hh[j] = hr[64 * j]; ga[j] = g1[64 * j]; gb[j] = g2[64 * j]; }
        if (m < MX) { const v2u* mr = (const v2u*)(MIX + (size_t)m * DM) + lane;
#pragma unroll
            for (int j = 0; j < 8; ++j) { const v2u w = mr[64 * j]; v[j] = (f32x4){bflo(w.x), bfhi(w.x), bflo(w.y), bfhi(w.y)}; } }
        else { const f32x4* mr = (const f32x4*)(MIXM + (size_t)(m - MX) * DM) + lane;
#pragma unroll
            for (int j = 0; j < 8; ++j) v[j] = mr[64 * j]; }
#pragma unroll
        for (int j = 0; j < 8; ++j) s += (v[j].x * v[j].x + v[j].y * v[j].y) + (v[j].z * v[j].z + v[j].w * v[j].w);
        const float rs = 1.0f / sqrtf(wave_sum(s) * (1.0f / DM) + RMS_EPS);
        float s2 = 0.f;
#pragma unroll
        for (int j = 0; j < 8; ++j) { v[j] = hh[j] + v[j] * rs * ga[j]; s2 += (v[j].x * v[j].x + v[j].y * v[j].y) + (v[j].z * v[j].z + v[j].w * v[j].w); }
        const float rs2 = 1.0f / sqrtf(wave_sum(s2) * (1.0f / DM) + RMS_EPS);
        v2u* o8 = (v2u*)(m < MX ? N2 + (size_t)m * DM : N2M + (size_t)(m - MX) * DM) + lane;
#pragma unroll
        for (int j = 0; j < 8; ++j) { const f32x4 g = gb[j]; o8[64 * j] = (v2u){pk2(v[j].x * rs2 * g.x, v[j].y * rs2 * g.y), pk2(v[j].z * rs2 * g.z, v[j].w * rs2 * g.w)}; }
    }
}
DI void phase6(const Args& A, int gtid, int NT) {
    unsigned char* ws = A.ws;
    const float* G4 = (const float*)(ws + WS_G4); const float* U2 = (const float*)(ws + WS_U2); const float* GM = (const float*)(ws + WS_GM); bf16* ACT = (bf16*)(ws + WS_ACT);
    const float* cw = A.in[20];
    constexpr int C4 = DFF / 4;
    for (int idx = gtid; idx < 256 * 2 * C4; idx += NT) {
        const int c4 = idx % C4, lr = (idx / C4) & 1, rb = idx / (2 * C4), col = c4 * 4;
        const f32x4 g0 = *(const f32x4*)(G4 + (size_t)(rb * 4 + lr) * DFF + col);
        const float* pm2; const float* pm1;
        const float* pb62 = (rb % 128 == 0) ? GM + col : G4 + (size_t)((rb - 1) * 4 + 2) * DFF + col;
        const float* pb63 = (rb % 128 == 0) ? GM + DFF + col : G4 + (size_t)((rb - 1) * 4 + 3) * DFF + col;
        if (lr == 0) { pm2 = pb62; pm1 = pb63; } else { pm2 = pb63; pm1 = G4 + (size_t)(rb * 4 + 0) * DFF + col; }
        const f32x4 gm2 = *(const f32x4*)pm2, gm1 = *(const f32x4*)pm1, up = *(const f32x4*)(U2 + (size_t)(rb * 2 + lr) * DFF + col);
        const f32x4 w0 = *(const f32x4*)(cw + col), w1 = *(const f32x4*)(cw + DFF + col), w2 = *(const f32x4*)(cw + 2 * DFF + col);
        float o[4];
#pragma unroll
        for (int x = 0; x < 4; ++x) { const float cv = w0[x] * gm2[x] + w1[x] * gm1[x] + w2[x] * g0[x]; o[x] = cv * __builtin_amdgcn_rcpf(1.0f + __expf(-cv)) * up[x]; }
        *(v2u*)(ACT + (size_t)(rb * 64 + lr) * DFF + col) = (v2u){pk2(o[0], o[1]), pk2(o[2], o[3])};
    }
}
DI void phase8(const Args& A, int gw, int NGW, int lane) {
    const bf16* F = (const bf16*)(A.ws + WS_F); const bf16* MIX = (const bf16*)(A.ws + WS_MIX);
    const f32x4* g1 = (const f32x4*)A.in[17] + lane; const f32x4* g4 = (const f32x4*)A.in[22] + lane;
    for (int m = gw; m < MX; m += NGW) {
        const v2u* fr = (const v2u*)(F + (size_t)m * DM) + lane; const v2u* mr = (const v2u*)(MIX + (size_t)m * DM) + lane;
        const f32x4* xr = (const f32x4*)(A.in[0] + (size_t)m * DM) + lane; f32x4* orow = (f32x4*)(A.out + (size_t)m * DM) + lane;
        f32x4 v[8], mx[8], hx[8], ga[8], gg[8]; float s = 0.f, sm = 0.f;
#pragma unroll
        for (int j = 0; j < 8; ++j) { hx[j] = xr[64 * j]; ga[j] = g1[64 * j]; gg[j] = g4[64 * j]; }
#pragma unroll
        for (int j = 0; j < 8; ++j) { const v2u w = mr[64 * j]; mx[j] = (f32x4){bflo(w.x), bfhi(w.x), bflo(w.y), bfhi(w.y)}; sm += (mx[j].x * mx[j].x + mx[j].y * mx[j].y) + (mx[j].z * mx[j].z + mx[j].w * mx[j].w); }
#pragma unroll
        for (int j = 0; j < 8; ++j) { const v2u w = fr[64 * j]; v[j] = (f32x4){bflo(w.x), bfhi(w.x), bflo(w.y), bfhi(w.y)}; s += (v[j].x * v[j].x + v[j].y * v[j].y) + (v[j].z * v[j].z + v[j].w * v[j].w); }
        const float rsm = 1.0f / sqrtf(wave_sum(sm) * (1.0f / DM) + RMS_EPS);
        const float rs = 1.0f / sqrtf(wave_sum(s) * (1.0f / DM) + RMS_EPS);
#pragma unroll
        for (int j = 0; j < 8; ++j) orow[64 * j] = (hx[j] + mx[j] * rsm * ga[j]) + v[j] * rs * gg[j];
    }
}
__global__ void __launch_bounds__(NTHR, 2) hymba_fwd(Args args) {
    extern __shared__ __attribute__((aligned(16))) unsigned char lds[];
    cg::grid_group grid = cg::this_grid();
    const int tid = threadIdx.x, lane = tid & 63, wave = __builtin_amdgcn_readfirstlane(tid >> 6);
    const int G = gridDim.x, bx = blockIdx.x;
    const int gw = bx * NWAVES + wave, NGW = G * NWAVES;
    PG8_LAS unsigned char* ldsg = (PG8_LAS unsigned char*)lds;
#ifdef PROBE_A
    unsigned long long* stamps = (unsigned long long*)args.ws; int nst = 0;
#define STAMP() do { if (bx == 0 && tid == 0) stamps[nst] = __builtin_amdgcn_s_memrealtime(); ++nst; } while (0)
#else
#define STAMP() do { } while (0)
#endif
    STAMP();
    volatile __attribute__((address_space(3))) unsigned* MISC = (volatile __attribute__((address_space(3))) unsigned*)(ldsg + LDS_BYTES - 64);
    if (tid < 16) MISC[tid] = 0u;
    __syncthreads();
    XcdBarrier bar = xcd_barrier_post((unsigned*)(args.ws + WS_BAR), MISC + 8);
    if (args.ws == nullptr) grid.sync();

    phase0(args, lds, gw, NGW, wave, lane);
    xcd_barrier(bar); STAMP();
    {
        pg8::Gemm g{(const bf16*)(args.ws + WS_BUFA), (const bf16*)(args.ws + WS_WIN), MP, IN_PAD, DM, DM, DM}; pg8::StaticOrder S; S.init(MP, IN_PAD, G, bx);
        pg8::EpiSplit2 E{(bf16*)(args.ws + WS_ZC), ZC_LD, (bf16*)(args.ws + WS_ZR), ZR_LD, ZC_LD};
        pg8::gemm_phase<pg8::EpiSplit2, pg8::StaticOrder, true, true>(ldsg, g, S, E);
    }
    xcd_barrier(bar); STAMP();
    phase2a(args, gw, NGW, lane);
    xcd_barrier(bar); STAMP();
    {
        if (wave == 0 && bx < 192) {
            const int n0 = bx * 16, seg = n0 >> 10, r16 = lane & 15, q = lane >> 4;
            const bf16* LAx = (const bf16*)(args.ws + (seg == 2 ? WS_LA2 : WS_LA1)); const bf16* WLx = seg == 2 ? (const bf16*)(args.ws + WS_WL2) + (size_t)(n0 - 2048) * 256 : (const bf16*)(args.ws + WS_WL1) + (size_t)n0 * 256;
            const int ks0 = seg == 1 ? 4 : 0, nks = seg == 2 ? 8 : 3;
            v4u af[8], bfr[8];
#pragma unroll
            for (int s = 0; s < 8; ++s) { const int sc = s < nks ? s : 0;
                af[s] = *(const v4u*)(LAx + (size_t)(MX + r16) * 256 + (ks0 + sc) * 32 + q * 8); bfr[s] = *(const v4u*)(WLx + (size_t)r16 * 256 + (ks0 + sc) * 32 + q * 8); }
            f32x4 acc = (f32x4){0.f, 0.f, 0.f, 0.f};
#pragma unroll
            for (int s = 0; s < 8; ++s) if (s < nks) acc = MFMA16(__builtin_bit_cast(bf16x8, af[s]), __builtin_bit_cast(bf16x8, bfr[s]), acc);
            bf16* dst = n0 < 2048 ? (bf16*)(args.ws + WS_LODA) : (bf16*)(args.ws + WS_LOG); const int ldd = n0 < 2048 ? 2048 : 1024, nc = (n0 < 2048 ? n0 : n0 - 2048) + r16;
#pragma unroll
            for (int jj = 0; jj < 4; ++jj) dst[(size_t)(MX + 4 * q + jj) * ldd + nc] = (bf16)f2bf(acc[jj]);
        }
        {
            pg8::Gemm g{(const bf16*)(args.ws + WS_LA1), (const bf16*)(args.ws + WS_WL1), MX, 2048, 256, 256, 256}; pg8::StaticOrder S; S.init(MX, 2048, G, bx);
            pg8::EpiSplit2 E{(bf16*)(args.ws + WS_LODA), 2048, nullptr, 0, 1 << 30};
            pg8::gemm_phase<pg8::EpiSplit2, pg8::StaticOrder, true, true>(ldsg, g, S, E);
        }
        {
            pg8::Gemm g{(const bf16*)(args.ws + WS_LA2), (const bf16*)(args.ws + WS_WL2), MX, 1024, 256, 256, 256}; pg8::StaticOrder S; S.init(MX, 1024, G, bx);
            pg8::EpiSplit2 E{(bf16*)(args.ws + WS_LOG), 1024, nullptr, 0, 1 << 30};
            pg8::gemm_phase<pg8::EpiSplit2, pg8::StaticOrder, true, true>(ldsg, g, S, E);
        }
    }
    xcd_barrier(bar); STAMP();
    phase_c1(args, lds, bx, G, tid, wave, lane);
    xcd_barrier(bar); STAMP();
    if (bx < 32) { if (wave < 4) phase_c2(args, bx, wave, lane);
#ifdef PROBE_A
        if (bx == 0 && tid == 0) stamps[20] = __builtin_amdgcn_s_memrealtime();
#endif
    }
    else {
        convert_late(args, lds, (bx - 32) * NWAVES + wave, (G - 32) * NWAVES, wave, lane);
        __syncthreads();
        pg8::Gemm g{(const bf16*)(args.ws + WS_BUFA), (const bf16*)(args.ws + WS_WOUT), MX, DM, 1024, DM, DM}; pg8::StaticOrder S; S.init(MX, DM, G - 32, bx - 32);
        pg8::EpiSplit2 E{(bf16*)args.out, DM, nullptr, 0, 1 << 30};
        pg8::gemm_phase<pg8::EpiSplit2, pg8::StaticOrder, true, true>(ldsg, g, S, E);
    }
    xcd_barrier(bar); STAMP();
    phase_c3(args, bx, G, wave, lane);
    xcd_barrier(bar); STAMP();
    {
        const bf16* YA = (const bf16*)(args.ws + WS_BUFA); const bf16* WOUT = (const bf16*)(args.ws + WS_WOUT); float* MIXM = (float*)(args.ws + WS_MIXM);
        for (int n = gw; n < DM; n += NGW) { const bf16* const br[1] = {WOUT + (size_t)n * DM}; float o0[1], o1[1];
            gemv2_rows<1>(YA + (size_t)(MX + 14) * DM, YA + (size_t)(MX + 15) * DM, br, lane, o0, o1); if (lane == 0) { MIXM[n] = o0[0]; MIXM[DM + n] = o1[0]; } }
        pg8::Gemm g{YA + 1024, WOUT + 1024, MX, DM, 1024, DM, DM}; pg8::StaticOrder S; S.init(MX, DM, G, bx);
        pg8::EpiAddBf16 E{(const bf16*)args.out, (bf16*)(args.ws + WS_MIX), DM};
        pg8::gemm_phase<pg8::EpiAddBf16, pg8::StaticOrder, true, true>(ldsg, g, S, E);
    }
    xcd_barrier(bar); STAMP();
    phase4(args, gw, NGW, lane);
    xcd_barrier(bar); STAMP();
    {
        const bf16* N2 = (const bf16*)(args.ws + WS_BUFA); const bf16* N2M = (const bf16*)(args.ws + WS_N2M); const bf16* WGU = (const bf16*)(args.ws + WS_WGU); float* GM = (float*)(args.ws + WS_GM);
        if (gw < DFF) {
            int jc[3]; const bf16* br[3]; float o0[3], o1[3];
#pragma unroll
            for (int c = 0; c < 3; ++c) { const int j = gw + c * NGW; jc[c] = j < DFF ? j : gw; br[c] = WGU + (size_t)(256 * (jc[c] >> 7) + (jc[c] & 127)) * DM; }
            gemv2_rows<3>(N2M, N2M + DM, br, lane, o0, o1);
            if (lane == 0) {
#pragma unroll
                for (int c = 0; c < 3; ++c) if (gw + c * NGW < DFF) { GM[jc[c]] = o0[c]; GM[DFF + jc[c]] = o1[c]; } }
        }
        pg8::Gemm g{N2, WGU, MX, 2 * DFF, DM, DM, DM}; pg8::StaticOrder S; S.init(MX, 2 * DFF, G, bx);
        pg8::EpiAct E{(bf16*)(args.ws + WS_ACT), (float*)(args.ws + WS_G4), (float*)(args.ws + WS_U2), args.in[20], DFF};
        pg8::gemm_phase<pg8::EpiAct, pg8::StaticOrder, true, true>(ldsg, g, S, E);
    }
    xcd_barrier(bar); STAMP();
    phase6(args, bx * NTHR + tid, G * NTHR);
    xcd_barrier(bar); STAMP();
    {
        pg8::Gemm g{(const bf16*)(args.ws + WS_ACT), (const bf16*)(args.ws + WS_WDN), MX, DM, DFF, DFF, DFF}; pg8::StaticOrder S; S.init(MX, DM, G, bx);
        pg8::EpiSplit2 E{(bf16*)(args.ws + WS_F), DM, nullptr, 0, 1 << 30};
        pg8::gemm_phase<pg8::EpiSplit2, pg8::StaticOrder, true, true>(ldsg, g, S, E);
    }
    xcd_barrier(bar); STAMP();
    phase8(args, gw, NGW, lane);
#ifdef PROBE_A
    xcd_barrier(bar); STAMP();
    if (bx == 0) {
        const float ta = PROBE_A == 100 ? (float)(stamps[20] - stamps[5]) * 0.01f : (float)(stamps[PROBE_A + 1] - stamps[PROBE_A]) * 0.01f;
        if (tid == 0) args.out[0] = ta * PROBE_SCALE;
    }
#endif
}

extern "C" void kernel_launch(void* const* d_in, const int* in_sizes, int n_in, void* d_out, int out_size, void* d_ws, size_t ws_size, hipStream_t stream) {
    static int grid = 0;
    if (grid == 0) {
        if (n_in != 23 || out_size != MX * DM || ws_size < WS_END) { fprintf(stderr, "kernel_launch: unexpected shapes (n_in %d, out %d, ws %zu)\n", n_in, out_size, ws_size); grid = -1; return; }
        int dev = 0, cus = 0, per_cu = 0;
        if (hipGetDevice(&dev) != hipSuccess || hipDeviceGetAttribute(&cus, hipDeviceAttributeMultiprocessorCount, dev) != hipSuccess) { grid = -1; return; }
        if (hipFuncSetAttribute((const void*)hymba_fwd, hipFuncAttributeMaxDynamicSharedMemorySize, LDS_BYTES) != hipSuccess) { fprintf(stderr, "kernel_launch: hipFuncSetAttribute failed\n"); grid = -1; return; }
        if (hipOccupancyMaxActiveBlocksPerMultiprocessor(&per_cu, (const void*)hymba_fwd, NTHR, LDS_BYTES) != hipSuccess || per_cu < 1) { fprintf(stderr, "kernel_launch: occupancy query says %d\n", per_cu); per_cu = 1; }
        (void)hipGetLastError();
        grid = (cus / 16) * 16;
        if (grid < 240) { fprintf(stderr, "kernel_launch: needs >= 240 CUs\n"); grid = -1; return; }
    }
    if (grid < 0) return;
    if (hipMemsetAsync((char*)d_ws, 0, 131072, stream) != hipSuccess) { fprintf(stderr, "kernel_launch: memset failed\n"); return; }
    Args a{};
    for (int i = 0; i < 23; ++i) a.in[i] = (const float*)d_in[i];
    a.out = (float*)d_out; a.ws = (unsigned char*)d_ws;
    void* kargs[] = {&a};
    hipError_t e = hipLaunchCooperativeKernel((const void*)hymba_fwd, dim3(grid), dim3(NTHR), kargs, LDS_BYTES, stream);
    if (e != hipSuccess) fprintf(stderr, "kernel_launch: cooperative launch failed: %s (grid %d)\n", hipGetErrorString(e), grid);
}
```

```cpp
#include <hip/hip_runtime.h>
#include <hip/hip_cooperative_groups.h>
#include <cstdio>
#include <cstdint>
namespace cg = cooperative_groups;
namespace pg8 {
#define PG8_LAS __attribute__((address_space(3)))
typedef unsigned short bf16_t;
typedef short bf16x8 __attribute__((ext_vector_type(8)));
typedef float f32x4 __attribute__((ext_vector_type(4)));
typedef unsigned u32x4 __attribute__((ext_vector_type(4)));
constexpr int BM = 256, BK = 64, HALF = 128, HTB = HALF * BK * 2  , STAGE_BYTES = 8 * HTB, NXCD = 8, WGM = 8;

__host__ __device__ __forceinline__ int lds_byte(int r, int c) { const int st = (r >> 4) * 2 + (c >> 5), rr = r & 15, cc = c & 31, ob = rr * 64 + cc * 2; return st * 1024 + (ob ^ (((ob >> 9) & 1) << 5)); }
__host__ __device__ __forceinline__ void stage_rc(int b, int& R, int& C) { const int st = b / 1024, sb = b % 1024, swz = sb ^ (((sb >> 9) & 1) << 5); R = (st >> 1) * 16 + swz / 64; C = (st & 1) * 32 + (swz % 64) / 2; }
__host__ __device__ __forceinline__ int perm32(int rho) { const int n = rho >> 4, i = rho & 15; return 8 * (i >> 2) + 4 * n + (i & 3); }

struct Unit { int pm, pn; };
struct Gemm { const bf16_t* A; const bf16_t* Bt; int M, N, K, lda, ldb; };

struct StaticOrder {
    int nM, nN, nwg, G, c;
    __host__ __device__ void init(int M, int N, int G_, int c_) { nM = M / BM; nN = N / BM; nwg = nM * nN; G = G_; c = c_; }
    __host__ __device__ bool next(int i, Unit& u) const {
        const long L = (long)i * G + c; if (L >= nwg) return false;
        int wgid = (int)L; { const int q = nwg / NXCD, r = nwg % NXCD, xcd = wgid % NXCD, off = wgid / NXCD; wgid = (xcd < r ? xcd * (q + 1) : r * (q + 1) + (xcd - r) * q) + off; }
        const int nig = WGM * nN, gid = wgid / nig, fm = gid * WGM, gsz = (nM - fm) < WGM ? (nM - fm) : WGM;
        u.pm = fm + ((wgid % nig) % gsz); u.pn = (wgid % nig) / gsz; return true;
    }
    __device__ __forceinline__ void a_ready(const Unit&) const {}
    __device__ __forceinline__ void done(const Unit&) const {}
};
__device__ __forceinline__ unsigned cvt_pk_bf16(float lo, float hi) { unsigned r; asm volatile("v_cvt_pk_bf16_f32 %0, %1, %2" : "=v"(r) : "v"(lo), "v"(hi)); return r; }
template <class Epi, class Sched, bool ALIGN_EPI = false, bool SP2 = false>
__device__ __forceinline__ void gemm_phase(PG8_LAS unsigned char* lds, const Gemm g, const Sched& S, const Epi& E) {
    int tid_ = threadIdx.x; asm volatile("" : "+v"(tid_));
    const int tid = tid_, wid = __builtin_amdgcn_readfirstlane(tid >> 6), lane = tid & 63, wr = wid >> 2, wc = wid & 3, fr = lane & 15, fq = lane >> 4;
    const int K = g.K, nt = K / BK;
    unsigned voffA[2], voffB[2];
#pragma unroll
    for (int i = 0; i < 2; ++i) { int R, C; stage_rc(tid * 16 + i * 8192, R, C); const int Rb = Epi::PERM ? ((R & ~31) + perm32(R & 31)) : R;
        voffA[i] = (unsigned)(R * g.lda + C) * 2u; voffB[i] = (unsigned)(Rb * g.ldb + C) * 2u; }
    const size_t kstep = (size_t)(BK * 2);
    const size_t hstepA = (size_t)HALF * g.lda * 2, hstepB = (size_t)HALF * g.ldb * 2;
    const size_t tstepA = 2 * hstepA, tstepB = 2 * hstepB;
    const unsigned ldsw = (unsigned)wid * 1024u;
    const int aoff = lds_byte(wr * 64 + fr, fq * 8), boff = lds_byte(wc * 32 + fr, fq * 8);
#define PG8_SA(b, h) (((b) * 2 + (h)) * HTB)
#define PG8_SB(b, h) ((4 + (b) * 2 + (h)) * HTB)
#define PG8_STAGE(bufoff, gbase, voff) do { _Pragma("unroll") for (int _i = 0; _i < 2; ++_i) \
        __builtin_amdgcn_global_load_lds((const unsigned*)((const char*)(gbase) + (voff)[_i]), (PG8_LAS unsigned*)(lds + (bufoff) + ldsw + _i * 8192), 16, 0, 0); } while (0)
#define PG8_LDA(dst, b, h) do { _Pragma("unroll") for (int m = 0; m < 4; ++m) _Pragma("unroll") for (int k = 0; k < 2; ++k) dst[m][k] = *(const PG8_LAS bf16x8*)(lds + PG8_SA(b, h) + aoff + m * 2048 + k * 1024); } while (0)
#define PG8_LDB(dst, b, h) do { _Pragma("unroll") for (int n = 0; n < 2; ++n) _Pragma("unroll") for (int k = 0; k < 2; ++k) dst[n][k] = *(const PG8_LAS bf16x8*)(lds + PG8_SB(b, h) + boff + n * 2048 + k * 1024); } while (0)
#define PG8_MMA(ai, bj, At, Bt) do { __builtin_amdgcn_s_setprio(1); _Pragma("unroll") for (int m = 0; m < 4; ++m) _Pragma("unroll") for (int n = 0; n < 2; ++n) _Pragma("unroll") for (int k = 0; k < 2; ++k) \
        acc[ai][bj][m][n] = __builtin_amdgcn_mfma_f32_16x16x32_bf16(Bt[n][k], At[m][k], acc[ai][bj][m][n], 0, 0, 0); __builtin_amdgcn_s_setprio(0); } while (0)
#define PG8_WAIT_V(n) asm volatile("s_waitcnt vmcnt(" #n ")" ::: "memory")
#define PG8_WAIT_L(n) asm volatile("s_waitcnt lgkmcnt(" #n ")" ::: "memory")
#define PG8_BAR __builtin_amdgcn_s_barrier()
#define PG8_SCHED __builtin_amdgcn_sched_barrier(0)
    Unit cur, nxt; int ui = 0;
    if (!S.next(0, cur)) return;
    f32x4 acc[2][2][4][2];
#pragma unroll
    for (int a = 0; a < 2; ++a)
#pragma unroll
        for (int b = 0; b < 2; ++b)
#pragma unroll
            for (int m = 0; m < 4; ++m)
#pragma unroll
                for (int n = 0; n < 2; ++n) acc[a][b][m][n] = (f32x4){0.f, 0.f, 0.f, 0.f};
    bf16x8 At[4][2], B0[2][2], B1[2][2];
    const char* cA = (const char*)g.A + (size_t)cur.pm * tstepA; const char* cB = (const char*)g.Bt + (size_t)cur.pn * tstepB;
    S.a_ready(cur);
    if constexpr (SP2) {
        PG8_STAGE(PG8_SB(0, 0), cB, voffB); PG8_STAGE(PG8_SB(0, 1), cB + hstepB, voffB); PG8_STAGE(PG8_SA(0, 0), cA, voffA); PG8_STAGE(PG8_SA(0, 1), cA + hstepA, voffA);
        if (wr == 1) PG8_BAR;
        PG8_WAIT_V(2); PG8_BAR;
        PG8_STAGE(PG8_SB(1, 0), cB + kstep, voffB); PG8_STAGE(PG8_SA(1, 0), cA + kstep, voffA); PG8_STAGE(PG8_SB(1, 1), cB + hstepB + kstep, voffB);
        PG8_WAIT_V(6); PG8_BAR;
    } else {
        PG8_STAGE(PG8_SB(0, 0), cB, voffB); PG8_STAGE(PG8_SA(0, 0), cA, voffA); PG8_STAGE(PG8_SB(0, 1), cB + hstepB, voffB); PG8_STAGE(PG8_SA(0, 1), cA + hstepA, voffA);
        if (wr == 1) PG8_BAR;
        PG8_WAIT_V(4); PG8_BAR;
        PG8_STAGE(PG8_SB(1, 0), cB + kstep, voffB); PG8_STAGE(PG8_SA(1, 0), cA + kstep, voffA); PG8_STAGE(PG8_SB(1, 1), cB + hstepB + kstep, voffB);
        PG8_WAIT_V(6); PG8_BAR;
    }
    for (;;) {
        const bool has_next = S.next(ui + 1, nxt);
        const char* nA = has_next ? (const char*)g.A + (size_t)nxt.pm * tstepA : cA; const char* nB = has_next ? (const char*)g.Bt + (size_t)nxt.pn * tstepB : cB;
        for (int t = 0; t < nt; t += 2) {
            const bool last = (t == nt - 2);
            const char* a1 = cA + (size_t)(t + 1) * kstep;
            const char* a2 = last ? nA : cA + (size_t)(t + 2) * kstep; const char* b2 = last ? nB : cB + (size_t)(t + 2) * kstep;
            const char* a3 = a2 + kstep; const char* b3 = b2 + kstep;
            if (last && has_next) S.a_ready(nxt);
            if constexpr (SP2) {
            PG8_LDB(B0, 0, 0); PG8_LDB(B1, 0, 1); PG8_SCHED; PG8_LDA(At, 0, 0); PG8_STAGE(PG8_SA(1, 1), a1 + hstepA, voffA);
            PG8_WAIT_V(8); PG8_WAIT_L(0); PG8_BAR; PG8_MMA(0, 0, At, B0); PG8_MMA(0, 1, At, B1); PG8_BAR; PG8_SCHED;
            PG8_LDA(At, 0, 1); PG8_STAGE(PG8_SB(0, 0), b2, voffB); PG8_STAGE(PG8_SB(0, 1), b2 + hstepB, voffB); PG8_STAGE(PG8_SA(0, 0), a2, voffA);
            PG8_WAIT_V(8); PG8_WAIT_L(0); PG8_BAR; PG8_MMA(1, 0, At, B0); PG8_MMA(1, 1, At, B1); PG8_BAR; PG8_SCHED;
            PG8_LDB(B0, 1, 0); PG8_LDB(B1, 1, 1); PG8_SCHED; PG8_LDA(At, 1, 0); PG8_STAGE(PG8_SA(0, 1), a2 + hstepA, voffA);
            PG8_WAIT_V(8); PG8_WAIT_L(0); PG8_BAR; PG8_MMA(0, 0, At, B0); PG8_MMA(0, 1, At, B1); PG8_BAR; PG8_SCHED;
            PG8_LDA(At, 1, 1); PG8_STAGE(PG8_SB(1, 0), b3, voffB); PG8_STAGE(PG8_SB(1, 1), b3 + hstepB, voffB); PG8_STAGE(PG8_SA(1, 0), a3, voffA);
            PG8_WAIT_V(8); PG8_WAIT_L(0); PG8_BAR; PG8_MMA(1, 0, At, B0); PG8_MMA(1, 1, At, B1); PG8_BAR; PG8_SCHED;
            } else {
            PG8_LDB(B0, 0, 0); PG8_SCHED; PG8_LDA(At, 0, 0); PG8_STAGE(PG8_SA(1, 1), a1 + hstepA, voffA);
            PG8_WAIT_L(8); PG8_BAR; PG8_WAIT_L(0); PG8_MMA(0, 0, At, B0); PG8_BAR; PG8_SCHED;
            PG8_LDB(B1, 0, 1); PG8_STAGE(PG8_SB(0, 0), b2, voffB);
            PG8_BAR; PG8_WAIT_L(0); PG8_MMA(0, 1, At, B1); PG8_BAR;
            PG8_LDA(At, 0, 1); PG8_STAGE(PG8_SA(0, 0), a2, voffA);
            PG8_BAR; PG8_WAIT_L(0); PG8_MMA(1, 0, At, B0); PG8_BAR; PG8_SCHED;
            PG8_STAGE(PG8_SB(0, 1), b2 + hstepB, voffB);
            PG8_WAIT_V(6); PG8_BAR; PG8_MMA(1, 1, At, B1); PG8_BAR;
            PG8_LDB(B0, 1, 0); PG8_SCHED; PG8_LDA(At, 1, 0); PG8_STAGE(PG8_SA(0, 1), a2 + hstepA, voffA);
            PG8_WAIT_L(8); PG8_BAR; PG8_WAIT_L(0); PG8_MMA(0, 0, At, B0); PG8_BAR; PG8_SCHED;
            PG8_LDB(B1, 1, 1); PG8_STAGE(PG8_SB(1, 0), b3, voffB);
            PG8_BAR; PG8_WAIT_L(0); PG8_MMA(0, 1, At, B1); PG8_BAR;
            PG8_LDA(At, 1, 1); PG8_STAGE(PG8_SA(1, 0), a3, voffA);
            PG8_BAR; PG8_WAIT_L(0); PG8_MMA(1, 0, At, B0); PG8_BAR; PG8_SCHED;
            PG8_STAGE(PG8_SB(1, 1), b3 + hstepB, voffB);
            PG8_WAIT_V(6); PG8_BAR; PG8_MMA(1, 1, At, B1); PG8_BAR;
            }
        }
        if constexpr (ALIGN_EPI) { if (wr == 0) PG8_BAR; }
        if constexpr (!Epi::AFTER_DRAIN) { E(acc, cur, wr, wc, fr, fq); S.done(cur); }
        if (!has_next) break;
#pragma unroll
        for (int a = 0; a < 2; ++a)
#pragma unroll
            for (int b = 0; b < 2; ++b)
#pragma unroll
                for (int m = 0; m < 4; ++m)
#pragma unroll
                    for (int n = 0; n < 2; ++n) acc[a][b][m][n] = (f32x4){0.f, 0.f, 0.f, 0.f};
        cur = nxt; cA = nA; cB = nB; ++ui;
        if constexpr (ALIGN_EPI) { if (wr == 1) PG8_BAR; }
    }
    PG8_WAIT_V(0);
    if constexpr (!ALIGN_EPI) { if (wr == 0) PG8_BAR; }
    PG8_BAR;
    if constexpr (Epi::AFTER_DRAIN) { E.fused(acc, cur, wr, wc, fr, fq, lds, wid, lane); S.done(cur); }
#undef PG8_SA
#undef PG8_SB
#undef PG8_STAGE
#undef PG8_LDA
#undef PG8_LDB
#undef PG8_MMA
#undef PG8_WAIT_V
#undef PG8_WAIT_L
#undef PG8_BAR
#undef PG8_SCHED
}
struct EpiSplit2 {
    static constexpr bool PERM = true, AFTER_DRAIN = false;
    bf16_t* O0; int ld0; bf16_t* O1; int ld1; int split_col;
    __device__ __forceinline__ void operator()(const f32x4 (&acc)[2][2][4][2], const Unit& u, int wr, int wc, int fr, int fq) const {
        const int row0 = u.pm * BM + wr * 64 + fr; int colt = u.pn * BM; bf16_t* base = O0; int ldc = ld0;
        if (colt >= split_col) { base = O1; ldc = ld1; colt -= split_col; }
        const int col0 = colt + wc * 32 + 8 * fq;
#pragma unroll
        for (int ai = 0; ai < 2; ++ai)
#pragma unroll
            for (int m = 0; m < 4; ++m) { bf16_t* rowp = base + (size_t)(row0 + ai * HALF + m * 16) * ldc + col0;
#pragma unroll
                for (int bj = 0; bj < 2; ++bj) { const f32x4 v0 = acc[ai][bj][m][0], v1 = acc[ai][bj][m][1];
                    u32x4 w; w.x = cvt_pk_bf16(v0[0], v0[1]); w.y = cvt_pk_bf16(v0[2], v0[3]); w.z = cvt_pk_bf16(v1[0], v1[1]); w.w = cvt_pk_bf16(v1[2], v1[3]);
                    *(u32x4*)(rowp + bj * HALF) = w; } }
    }
};
struct EpiF32 {
    static constexpr bool PERM = false, AFTER_DRAIN = false;
    float* C; int ldc;
    __device__ __forceinline__ void operator()(const f32x4 (&acc)[2][2][4][2], const Unit& u, int wr, int wc, int fr, int fq) const {
        const int row0 = u.pm * BM + wr * 64 + fr, col0 = u.pn * BM + wc * 32 + 4 * fq;
#pragma unroll
        for (int ai = 0; ai < 2; ++ai)
#pragma unroll
            for (int m = 0; m < 4; ++m) { float* rowp = C + (size_t)(row0 + ai * HALF + m * 16) * ldc + col0;
#pragma unroll
                for (int bj = 0; bj < 2; ++bj)
#pragma unroll
                    for (int n = 0; n < 2; ++n) *(f32x4*)(rowp + bj * HALF + n * 16) = acc[ai][bj][m][n]; }
    }
};
struct EpiAct {
    static constexpr bool PERM = true, AFTER_DRAIN = false;
    bf16_t* ACT; float* G4; float* U2; const float* cw; int dff;
    __device__ __forceinline__ void operator()(const f32x4 (&acc)[2][2][4][2], const Unit& u, int wr, int wc, int fr, int fq) const {
        const int lane = (int)(threadIdx.x & 63);
        const int colg = u.pn * HALF + wc * 32 + 8 * fq;
        const int src1 = (lane & 48) | ((fr + 15) & 15), src2 = (lane & 48) | ((fr + 14) & 15);
        f32x4 w0[2], w1[2], w2[2];
#pragma unroll
        for (int n = 0; n < 2; ++n) { w0[n] = *(const f32x4*)(cw + colg + 4 * n); w1[n] = *(const f32x4*)(cw + dff + colg + 4 * n); w2[n] = *(const f32x4*)(cw + 2 * dff + colg + 4 * n); }
#pragma unroll
        for (int ai = 0; ai < 2; ++ai) {
            const int rowb = u.pm * BM + ai * HALF + wr * 64;
            const int rb = rowb >> 6;
            f32x4 c1[2], c2[2];
#pragma unroll
            for (int n = 0; n < 2; ++n) { c1[n] = (f32x4){0.f, 0.f, 0.f, 0.f}; c2[n] = c1[n]; }
#pragma unroll
            for (int m = 0; m < 4; ++m) {
                u32x4 wout; unsigned pk[4];
#pragma unroll
                for (int n = 0; n < 2; ++n) {
                    const f32x4 g = acc[ai][0][m][n], up = acc[ai][1][m][n];
                    f32x4 s1, s2, o;
#pragma unroll
                    for (int x = 0; x < 4; ++x) { s1[x] = __shfl(g[x], src1); s2[x] = __shfl(g[x], src2); }
#pragma unroll
                    for (int x = 0; x < 4; ++x) {
                        const float p1 = fr >= 1 ? s1[x] : c1[n][x], p2 = fr >= 2 ? s2[x] : c2[n][x];
                        const float cv = w0[n][x] * p2 + w1[n][x] * p1 + w2[n][x] * g[x];
                        o[x] = cv * __builtin_amdgcn_rcpf(1.0f + __expf(-cv)) * up[x];
                    }
                    c1[n] = s1; c2[n] = s2;
                    pk[2 * n] = cvt_pk_bf16(o[0], o[1]); pk[2 * n + 1] = cvt_pk_bf16(o[2], o[3]);
                    if (m == 0 && fr < 2) { *(f32x4*)(G4 + (size_t)(rb * 4 + fr) * dff + colg + 4 * n) = g; *(f32x4*)(U2 + (size_t)(rb * 2 + fr) * dff + colg + 4 * n) = up; }
                    if (m == 3 && fr >= 14) { *(f32x4*)(G4 + (size_t)(rb * 4 + 2 + (fr - 14)) * dff + colg + 4 * n) = g; }
                }
                wout.x = pk[0]; wout.y = pk[1]; wout.z = pk[2]; wout.w = pk[3];
                *(u32x4*)(ACT + (size_t)(rowb + m * 16 + fr) * dff + colg) = wout;
            }
        }
    }
};
struct EpiAddBf16 {
    static constexpr bool PERM = true, AFTER_DRAIN = false;
    const bf16_t* P; bf16_t* O; int ldc;
    __device__ __forceinline__ void operator()(const f32x4 (&acc)[2][2][4][2], const Unit& u, int wr, int wc, int fr, int fq) const {
        const int row0 = u.pm * BM + wr * 64 + fr, col0 = u.pn * BM + wc * 32 + 8 * fq;
#pragma unroll
        for (int ai = 0; ai < 2; ++ai)
#pragma unroll
            for (int m = 0; m < 4; ++m) { const size_t off = (size_t)(row0 + ai * HALF + m * 16) * ldc + col0;
#pragma unroll
                for (int bj = 0; bj < 2; ++bj) { const f32x4 v0 = acc[ai][bj][m][0], v1 = acc[ai][bj][m][1];
                    const u32x4 p = *(const u32x4*)(P + off + bj * HALF);
                    u32x4 w;
                    w.x = cvt_pk_bf16(v0[0] + __builtin_bit_cast(float, p.x << 16), v0[1] + __builtin_bit_cast(float, p.x & 0xffff0000u));
                    w.y = cvt_pk_bf16(v0[2] + __builtin_bit_cast(float, p.y << 16), v0[3] + __builtin_bit_cast(float, p.y & 0xffff0000u));
                    w.z = cvt_pk_bf16(v1[0] + __builtin_bit_cast(float, p.z << 16), v1[1] + __builtin_bit_cast(float, p.z & 0xffff0000u));
                    w.w = cvt_pk_bf16(v1[2] + __builtin_bit_cast(float, p.w << 16), v1[3] + __builtin_bit_cast(float, p.w & 0xffff0000u));
                    *(u32x4*)(O + off + bj * HALF) = w; } }
    }
};
}
constexpr int DM = 2048, NBATCH = 2, SEQ = 8192, NMETA = 16;
constexpr int MX = NBATCH * SEQ;
constexpr int MROWS = MX + NMETA;
constexpr int MP = 16640;
constexpr int LSEQ = SEQ + NMETA;
constexpr int NCH = 129;
constexpr int NHEAD = 16;
constexpr int IN_COLS = 6592, IN_PAD = 6656, ZC_LD = 3072, ZR_LD = 3584;
constexpr int DFF = 5632;
constexpr int NITEM = NBATCH * NCH * NHEAD;
constexpr float RMS_EPS = 1e-6f, GN_EPS = 64e-5f, DECAY_SCALE = 0.60653065971263342f;
constexpr int NWAVES = 8, NTHR = 512;
constexpr int LDS_BYTES = 147456;
constexpr size_t MiB = 1u << 20;
constexpr size_t WS_BAR = 65536;
constexpr size_t WS_WIN = 1 * MiB, WS_WOUT = 27 * MiB, WS_WLORA = 35 * MiB, WS_BUFA = 38 * MiB;
constexpr size_t WS_ZR = 103 * MiB, WS_LODA = 217 * MiB, WS_LOG = 282 * MiB, WS_ZC = 315 * MiB, WS_LA = 413 * MiB;
constexpr size_t WS_LA1 = WS_LA, WS_LA2 = WS_LA + (size_t)MP * 256 * 2, WS_WL1 = WS_WLORA, WS_WL2 = WS_WLORA + (size_t)2048 * 256 * 2;
constexpr size_t WS_MF = 315 * MiB, C1ARR = (size_t)NITEM * 8192, WS_QF = WS_MF + C1ARR, WS_NB = WS_QF + C1ARR, WS_Y1 = WS_NB + C1ARR;
constexpr size_t WS_HST = 444 * MiB, WS_BON = 476 * MiB + 512 * 1024;
constexpr size_t WS_WGU = 217 * MiB, WS_WDN = 478 * MiB;
constexpr size_t WS_MIX = 103 * MiB, WS_ACT = 262 * MiB, WS_G4 = 438 * MiB, WS_U2 = 460 * MiB, WS_F = 167 * MiB;
constexpr size_t WS_MIXM = 501 * MiB, WS_N2M = 501 * MiB + 256 * 1024, WS_GM = 501 * MiB + 512 * 1024, WS_END = 502 * MiB;
static_assert(WS_Y1 + C1ARR <= WS_HST && WS_HST + C1ARR <= WS_BON && WS_BON + (size_t)NBATCH * NCH * 64 * NHEAD * 4 <= WS_WDN, "ws map");

typedef unsigned short bf16;
typedef unsigned v4u __attribute__((ext_vector_type(4)));
typedef unsigned v2u __attribute__((ext_vector_type(2)));
typedef float f32x4 __attribute__((ext_vector_type(4)));
typedef short bf16x8 __attribute__((ext_vector_type(8)));
#define LDS_WAIT() asm volatile("s_waitcnt lgkmcnt(0)" ::: "memory")
#define DI __device__ __forceinline__
typedef float f32x2_t __attribute__((ext_vector_type(2)));
typedef __bf16 bf16x2_t __attribute__((ext_vector_type(2)));
DI unsigned pk2(float lo, float hi) { const f32x2_t v = {lo, hi}; const bf16x2_t r = __builtin_convertvector(v, bf16x2_t); return __builtin_bit_cast(unsigned, r); }
DI unsigned f2bf(float f) { return pk2(f, 0.f) & 0xffffu; }
DI float bflo(unsigned w) { return __builtin_bit_cast(float, w << 16); }
DI float bfhi(unsigned w) { return __builtin_bit_cast(float, w & 0xffff0000u); }
DI float bf2f(bf16 b) { return __builtin_bit_cast(float, ((unsigned)b) << 16); }
DI void unpack8(const v4u w, float (&o)[8]) { o[0] = bflo(w.x); o[1] = bfhi(w.x); o[2] = bflo(w.y); o[3] = bfhi(w.y); o[4] = bflo(w.z); o[5] = bfhi(w.z); o[6] = bflo(w.w); o[7] = bfhi(w.w); }
DI v4u pack8(const float (&o)[8]) { v4u w; w.x = pk2(o[0], o[1]); w.y = pk2(o[2], o[3]); w.z = pk2(o[4], o[5]); w.w = pk2(o[6], o[7]); return w; }
DI float sigmoidf_(float x) { return __builtin_amdgcn_rcpf(1.0f + __expf(-x)); }
DI float wave_sum(float v) {
#pragma unroll
    for (int o = 1; o < 64; o <<= 1) v += __shfl_xor(v, o);
    return v;
}
DI int prev_row(int t) { if (t >= MX) return t == MX ? -1 : t - 1; return (t % SEQ == 0) ? (MX + NMETA - 1) : t - 1; }

struct Args { const float* in[23]; float* out; unsigned char* ws; };

DI void tr_item(const float* W, int N, bf16* WT, int Kd, int k0, int n0, int drow0, float* scr, int lane) {
    float tv[64];
#pragma unroll
    for (int i = 0; i < 64; ++i) tv[i] = W[(size_t)(k0 + i) * N + n0 + lane];
#pragma unroll
    for (int i = 0; i < 64; ++i) scr[i * 65 + lane] = tv[i];
    LDS_WAIT();
    const int c = lane & 7;
#pragma unroll
    for (int j = 0; j < 8; ++j) { const int n = (lane >> 3) + 8 * j; const float* s = scr + (8 * c) * 65 + n;
        v4u o; o.x = pk2(s[0 * 65], s[1 * 65]); o.y = pk2(s[2 * 65], s[3 * 65]); o.z = pk2(s[4 * 65], s[5 * 65]); o.w = pk2(s[6 * 65], s[7 * 65]);
        *(v4u*)(WT + (size_t)(drow0 + n) * Kd + k0 + 8 * c) = o; }
    LDS_WAIT();
}
DI void rms_row_bf16(const float* src, const float* gain, bf16* dst, int lane) {
    v2u* o8 = (v2u*)dst + lane;
    if (!src) {
#pragma unroll
        for (int j = 0; j < 8; ++j) o8[64 * j] = (v2u){0u, 0u};
        return; }
    const f32x4* xr = (const f32x4*)src + lane; const f32x4* gr = (const f32x4*)gain + lane;
    f32x4 v[8], g[8]; float s = 0.f;
#pragma unroll
    for (int j = 0; j < 8; ++j) { v[j] = xr[64 * j]; g[j] = gr[64 * j]; }
#pragma unroll
    for (int j = 0; j < 8; ++j) s += (v[j].x * v[j].x + v[j].y * v[j].y) + (v[j].z * v[j].z + v[j].w * v[j].w);
    const float rs = 1.0f / sqrtf(wave_sum(s) * (1.0f / DM) + RMS_EPS);
#pragma unroll
    for (int j = 0; j < 8; ++j) o8[64 * j] = (v2u){pk2(v[j].x * rs * g[j].x, v[j].y * rs * g[j].y), pk2(v[j].z * rs * g[j].z, v[j].w * rs * g[j].w)};
}
template <int NC>
DI void gemv2_rows(const bf16* a0, const bf16* a1, const bf16* const (&brow)[NC], int lane, float (&o0)[NC], float (&o1)[NC]) {
    v4u xa[4], xb[4], w[NC][4];
#pragma unroll
    for (int i = 0; i < 4; ++i) { xa[i] = *(const v4u*)(a0 + lane * 8 + 512 * i); xb[i] = *(const v4u*)(a1 + lane * 8 + 512 * i); }
#pragma unroll
    for (int c = 0; c < NC; ++c)
#pragma unroll
        for (int i = 0; i < 4; ++i) w[c][i] = *(const v4u*)(brow[c] + lane * 8 + 512 * i);
#pragma unroll
    for (int c = 0; c < NC; ++c) {
        float s0 = 0.f, s1 = 0.f;
#pragma unroll
        for (int i = 0; i < 4; ++i) { float x0[8], x1[8], ww[8]; unpack8(xa[i], x0); unpack8(xb[i], x1); unpack8(w[c][i], ww);
#pragma unroll
            for (int e = 0; e < 8; ++e) { s0 += x0[e] * ww[e]; s1 += x1[e] * ww[e]; } }
        o0[c] = wave_sum(s0); o1[c] = wave_sum(s1);
    }
}
#define XB_TMO      128
#define XB_XCNT(j)  (256  + 64 * (j))
#define XB_XSUB(j)  (1280 + 64 * (j))
#define XB_XGEN(j)  (2304 + 64 * (j))
#define XB_TOP      3328
#define XB_TOPGEN   3392
#define XCD_BAR_WORDS 3456
#define XB_SPIN_CAP (1u << 18)

__device__ __forceinline__ unsigned xb_ld(unsigned* p)              { return __hip_atomic_load(p, __ATOMIC_RELAXED, __HIP_MEMORY_SCOPE_AGENT); }
__device__ __forceinline__ unsigned xb_add(unsigned* p, unsigned v) { return __hip_atomic_fetch_add(p, v, __ATOMIC_RELAXED, __HIP_MEMORY_SCOPE_AGENT); }
__device__ __forceinline__ unsigned xb_xcc_id() { return (unsigned)__builtin_amdgcn_s_getreg((3 << 11) | 20) & 0xFu; }
#define XB_SPIN(cond, bar) do { unsigned _sp = 0; while (cond) { __builtin_amdgcn_s_sleep(1); \
    if ((++_sp & 255u) == 0u) { if (xb_ld(&(bar)[XB_TMO])) break; if (_sp > XB_SPIN_CAP) { atomicAdd(&(bar)[XB_TMO], 1u); break; } } } } while (0)

struct XcdBarrier {
    unsigned* bar; unsigned x;
    volatile __attribute__((address_space(3))) unsigned* st;
};

__device__ __forceinline__ XcdBarrier xcd_barrier_post(unsigned* bar, volatile __attribute__((address_space(3))) unsigned* st) {
    XcdBarrier b; b.bar = bar; b.x = xb_xcc_id(); b.st = st;
    if (threadIdx.x == 0) (void)xb_add(&bar[XB_XCNT(b.x)], 1u);
    return b;
}
__device__ __forceinline__ void xcd_barrier_complete(unsigned* bar, unsigned x, unsigned& nloc, unsigned& nx) {
    const unsigned G = gridDim.x * gridDim.y * gridDim.z;
    unsigned sum, cnt, mine, sp = 0u;
    for (;;) {
        sum = 0u; cnt = 0u; mine = 0u;
#pragma unroll
        for (unsigned j = 0; j < 16; ++j) { const unsigned c = xb_ld(&bar[XB_XCNT(j)]); sum += c; cnt += (c > 0u) ? 1u : 0u; mine = (j == x) ? c : mine; }
        if (sum == G) break;
        __builtin_amdgcn_s_sleep(1);
        if ((++sp & 255u) == 0u) { if (xb_ld(&bar[XB_TMO])) break; if (sp > XB_SPIN_CAP) { atomicAdd(&bar[XB_TMO], 1u); break; } }
    }
    nloc = mine > 0u ? mine : 1u; nx = cnt > 0u ? cnt : 1u;
}

__device__ __forceinline__ void xcd_barrier(const XcdBarrier& b) {
    asm volatile("s_waitcnt vmcnt(0)" ::: "memory");
    __syncthreads();
    if (threadIdx.x == 0) {
        unsigned* bar = b.bar;
        __builtin_amdgcn_s_waitcnt(0);
        unsigned nloc = b.st[0], nx = b.st[1];
        if (nloc == 0u) { xcd_barrier_complete(bar, b.x, nloc, nx); b.st[0] = nloc; b.st[1] = nx; }
        const unsigned old = xb_add(&bar[XB_XSUB(b.x)], 1u);
        const unsigned gen = old / nloc;
        if (old + 1u == (gen + 1u) * nloc) {
            __builtin_amdgcn_fence(__ATOMIC_RELEASE, "agent");
            asm volatile("s_waitcnt vmcnt(0)" ::: "memory");
            const unsigned og = xb_add(&bar[XB_TOP], 1u);
            const unsigned tg = og / nx;
            if (og + 1u == (tg + 1u) * nx) xb_add(&bar[XB_TOPGEN], 1u);
            else XB_SPIN(xb_ld(&bar[XB_TOPGEN]) == tg, bar);
            __builtin_amdgcn_fence(__ATOMIC_ACQUIRE, "agent");
            xb_add(&bar[XB_XGEN(b.x)], 1u);
            asm volatile("s_waitcnt vmcnt(0)" ::: "memory");
        } else {
            XB_SPIN(xb_ld(&bar[XB_XGEN(b.x)]) == gen, bar);
            __builtin_amdgcn_fence(__ATOMIC_ACQUIRE, "agent");
            asm volatile("s_waitcnt vmcnt(0)" ::: "memory");
        }
    }
    __syncthreads();
}

DI void phase0(const Args& A, unsigned char* lds, int gw, int NGW, int wave, int lane) {
    unsigned char* ws = A.ws;
    float* scr = (float*)(lds + wave * 16640);
    bf16* WIN = (bf16*)(ws + WS_WIN); bf16* WOUT = (bf16*)(ws + WS_WOUT);
    constexpr int I_IN = (DM / 64) * (IN_COLS / 64), I_OUT = (DM / 64) * (DM / 64);
    for (int it = gw; it < I_IN + I_OUT; it += NGW) {
        if (it < I_IN) { const int kb = it / (IN_COLS / 64), nb = it % (IN_COLS / 64); tr_item(A.in[3], IN_COLS, WIN, DM, kb * 64, nb * 64, nb * 64, scr, lane); }
        else { const int r = it - I_IN, kb = r / (DM / 64), nb = r % (DM / 64); tr_item(A.in[16], DM, WOUT, DM, kb * 64, nb * 64, nb * 64, scr, lane); }
    }
    for (int i = gw * 64 + lane; i < (IN_PAD - IN_COLS) * DM / 8; i += NGW * 64) ((v4u*)(WIN + (size_t)IN_COLS * DM))[i] = (v4u){0u, 0u, 0u, 0u};
    { bf16* WL1 = (bf16*)(ws + WS_WL1); bf16* WL2 = (bf16*)(ws + WS_WL2);
#pragma unroll 4
      for (int i = gw * 64 + lane; i < 2048 * 256; i += NGW * 64) {
          const int n = i >> 8, k = i & 255, seg = n >> 10;
          const bool ok = seg == 0 ? (k < 96) : (k >= 128 && k < 224);
          const float* srcp = seg == 0 ? A.in[6] : A.in[8];
          const int kk = seg == 0 ? k : k - 128;
          const float v = srcp[ok ? kk * 1024 + (n & 1023) : 0];
          WL1[i] = ok ? (bf16)f2bf(v) : (bf16)0;
      }
#pragma unroll 4
      for (int i = gw * 64 + lane; i < 1024 * 256; i += NGW * 64) { const int n = i >> 8, k = i & 255; WL2[i] = (bf16)f2bf(A.in[10][k * 1024 + n]); }
    }
    bf16* XN = (bf16*)(ws + WS_BUFA);
    for (int m = gw; m < MP; m += NGW) {
        const float* src = m < MX ? A.in[0] + (size_t)m * DM : (m < MROWS ? A.in[1] + (size_t)(m - MX) * DM : nullptr);
        rms_row_bf16(src, A.in[2], XN + (size_t)m * DM, lane);
    }
}
DI void convert_late(const Args& A, unsigned char* lds, int cw, int NCW, int wave, int lane, int it_lo, int it_hi) {
    unsigned char* ws = A.ws; float* scr = (float*)(lds + wave * 16640);
    bf16* WGU = (bf16*)(ws + WS_WGU); bf16* WDN = (bf16*)(ws + WS_WDN);
    constexpr int I_GU = (DM / 64) * (2 * DFF / 64), I_DN = (DFF / 64) * (DM / 64);
    for (int it = it_lo + cw; it < it_hi; it += NCW) {
        if (it < I_GU) { const int kb = it / (2 * DFF / 64), nb = it % (2 * DFF / 64); const int n0 = nb * 64; const int j = n0 < DFF ? n0 : n0 - DFF;
            const int drow = 256 * (j >> 7) + (n0 < DFF ? 0 : 128) + (j & 127);
            tr_item(A.in[19], 2 * DFF, WGU, DM, kb * 64, n0, drow, scr, lane); }
        else { const int r = it - I_GU, kb = r / (DM / 64), nb = r % (DM / 64); tr_item(A.in[21], DM, WDN, DFF, kb * 64, nb * 64, nb * 64, scr, lane); }
    }
}
DI void phase2a(const Args& A, int gw, int NGW, int lane) {
    unsigned char* ws = A.ws;
    const bf16* ZC = (const bf16*)(ws + WS_ZC); const bf16* ZR = (const bf16*)(ws + WS_ZR); bf16* YA = (bf16*)(ws + WS_BUFA); bf16* LA = (bf16*)(ws + WS_LA);
    const float* cwp = A.in[4]; const float* mu = A.in[5];
    float w0[16], w1[16], w2[16];
#pragma unroll
    for (int e4 = 0; e4 < 4; ++e4) { const f32x4 a = *(const f32x4*)(cwp + lane * 16 + 4 * e4), b = *(const f32x4*)(cwp + 1024 + lane * 16 + 4 * e4), c = *(const f32x4*)(cwp + 2048 + lane * 16 + 4 * e4);
#pragma unroll
        for (int x = 0; x < 4; ++x) { w0[4 * e4 + x] = a[x]; w1[4 * e4 + x] = b[x]; w2[4 * e4 + x] = c[x]; } }
    int src = 0, kind = 0;
    if (lane < 12) { src = 3072 + 8 * lane; kind = 1; } else if (lane >= 16 && lane < 28) { src = 3168 + 8 * (lane - 16); kind = 2; } else if (lane >= 32) { src = 3264 + 8 * (lane - 32); kind = 3; }
    float mus[8];
    { const f32x4 a = *(const f32x4*)(mu + src), b = *(const f32x4*)(mu + src + 4); mus[0] = a.x; mus[1] = a.y; mus[2] = a.z; mus[3] = a.w; mus[4] = b.x; mus[5] = b.y; mus[6] = b.z; mus[7] = b.w; }
    for (int t = gw; t < MROWS; t += NGW) {
        const int t1 = prev_row(t), t2 = t1 >= 0 ? prev_row(t1) : -1;
        const int r1 = t1 >= 0 ? t1 : t, r2 = t2 >= 0 ? t2 : t;
        const float f1 = t1 >= 0 ? 1.f : 0.f, f2 = t2 >= 0 ? 1.f : 0.f;
        v4u lb[2], lc0[2], lh0[2], lc1[2], lh1[2], lc2[2], lh2[2];
#pragma unroll
        for (int hv = 0; hv < 2; ++hv) {
            const int c8 = lane * 16 + hv * 8;
            const bf16* z0 = ZC + (size_t)t * ZC_LD + c8; const bf16* z1 = ZC + (size_t)r1 * ZC_LD + c8; const bf16* z2 = ZC + (size_t)r2 * ZC_LD + c8;
            lb[hv] = *(const v4u*)z0; lc0[hv] = *(const v4u*)(z0 + 1024); lh0[hv] = *(const v4u*)(z0 + 2048);
            lc1[hv] = *(const v4u*)(z1 + 1024); lh1[hv] = *(const v4u*)(z1 + 2048); lc2[hv] = *(const v4u*)(z2 + 1024); lh2[hv] = *(const v4u*)(z2 + 2048);
        }
        const v4u lz = *(const v4u*)(ZR + (size_t)t * ZR_LD + src), lzp = *(const v4u*)(ZR + (size_t)r1 * ZR_LD + src);
#pragma unroll
        for (int hv = 0; hv < 2; ++hv) {
            const int c8 = lane * 16 + hv * 8;
            float bv[8], c0[8], h0[8], c1[8], h1[8], c2[8], h2[8], o[8];
            unpack8(lb[hv], bv); unpack8(lc0[hv], c0); unpack8(lh0[hv], h0); unpack8(lc1[hv], c1); unpack8(lh1[hv], h1); unpack8(lc2[hv], c2); unpack8(lh2[hv], h2);
#pragma unroll
            for (int e = 0; e < 8; ++e) o[e] = bv[e] * (w0[hv * 8 + e] * (f2 * c2[e] * h2[e]) + w1[hv * 8 + e] * (f1 * c1[e] * h1[e]) + w2[hv * 8 + e] * (c0[e] * h0[e]));
            *(v4u*)(YA + (size_t)t * DM + c8) = pack8(o);
        }
        v4u outw = (v4u){0u, 0u, 0u, 0u};
        if (kind != 0) {
            float z[8], zp[8], o[8]; unpack8(lz, z); unpack8(lzp, zp);
#pragma unroll
            for (int e = 0; e < 8; ++e) { const float s = z[e] + (f1 * zp[e] - z[e]) * mus[e];
                const float th = 1.0f - 2.0f * __builtin_amdgcn_rcpf(1.0f + __expf(2.0f * s));
                o[e] = kind == 1 ? th : (kind == 2 ? s : sigmoidf_(s)); }
            outw = pack8(o);
        }
        *(v4u*)(lane < 32 ? LA + (size_t)t * 256 + 8 * lane : LA + (size_t)MP * 256 + (size_t)t * 256 + 8 * (lane - 32)) = outw;
    }
}
constexpr int LP = 144;
constexpr int L_AT = 0, L_BT = 9216, L_KT = 18432, L_RT = 27648, L_BHT = 36864, L_KHT = 46080, L_VT = 55296, L_AAK = 64512, L_ARB = 73728, L_ARK = 82944, L_AAB = 92160;
constexpr int L_WT = 101376;
constexpr int L_GC = 103424;
constexpr int L_TD = 103680;
constexpr int L_PAR = 105728;
constexpr int L_XT = L_BT;
constexpr int L_SQ = L_AT, L_SM = L_BT, L_SN = L_KT, L_SY = L_RT;
static_assert(L_PAR + 2048 <= 131072, "lds");
#define MFMA16(a, b, c) __builtin_amdgcn_mfma_f32_16x16x32_bf16((a), (b), (c), 0, 0, 0)
DI bf16x8 ldfrag(const unsigned char* base, int row, int s, int q) { return *(const bf16x8*)(base + row * LP + (s * 32 + q * 8) * 2); }
DI bf16x8 ldfrag_sw(const unsigned char* base, int row, int s, int q) { return *(const bf16x8*)(base + row * LP + (((s * 4 + q) ^ ((row >> 3) & 7)) * 16)); }
DI void st_bf(unsigned char* base, int row, int col, float v) { *(bf16*)(base + row * LP + col * 2) = (bf16)f2bf(v); }
DI bf16x8 half_frag(v2u lo) { v4u w; w.x = lo.x; w.y = lo.y; w.z = 0u; w.w = 0u; return __builtin_bit_cast(bf16x8, w); }

struct C1Raw { v4u z[3], zp[3], dec, aa; };
DI void c1_rows(int b, int c, int i, int& pos, bool& valid, int& row, int& prow) {
    pos = c * 64 + i; valid = pos < LSEQ;
    row = valid ? (pos < NMETA ? MX + pos : b * SEQ + pos - NMETA) : 0; prow = prev_row(row);
}
DI void c1_load(C1Raw& R, const bf16* ZR, const bf16* LODA, int b, int c, int i, int col) {
    int pos, row, prow; bool valid; c1_rows(b, c, i, pos, valid, row, prow);
    const bf16* zr = ZR + (size_t)row * ZR_LD + col; const bf16* zpr = ZR + (size_t)(prow >= 0 ? prow : 0) * ZR_LD + col;
#pragma unroll
    for (int p = 0; p < 3; ++p) { R.z[p] = *(const v4u*)(zr + p * 1024); R.zp[p] = *(const v4u*)(zpr + p * 1024); }
    R.dec = *(const v4u*)(LODA + (size_t)row * 2048 + col); R.aa = *(const v4u*)(LODA + (size_t)row * 2048 + 1024 + col);
}

DI void phase_c1(const Args& A, unsigned char* lds_, int bx, int G, int tid, int wave, int lane) {
    unsigned char* ws = A.ws;
    const bf16* ZR = (const bf16*)(ws + WS_ZR); const bf16* LODA = (const bf16*)(ws + WS_LODA);
    float* BON = (float*)(ws + WS_BON);
    const int r16 = lane & 15, q = lane >> 4;
    const int tm = wave >> 1, tn0 = (wave & 1) * 2;
    const int h = bx & 15, NBC = NBATCH * NCH, bc0 = bx >> 4, bcs = G >> 4;
    const int i = tid >> 3, cgp = tid & 7, c0 = cgp * 8, col = h * 64 + c0;
    { float* PAR = (float*)(lds_ + L_PAR); const int pa = tid >> 6, ch = tid & 63; const float* src = pa < 3 ? A.in[5] + pa * 1024 : (pa == 3 ? A.in[7] : pa == 4 ? A.in[9] : pa == 5 ? A.in[11] : pa == 6 ? A.in[12] : A.in[13]);
      PAR[pa * 64 + ch] = src[h * 64 + ch]; }
    __syncthreads();
    if (bc0 >= NBC) return;
    C1Raw cur; c1_load(cur, ZR, LODA, bc0 / NCH, bc0 % NCH, i, col);
    for (int bc = bc0; bc < NBC; bc += bcs) {
        int oz = 0; asm volatile("" : "+s"(oz));
        unsigned char* L = lds_ + oz; float* WT = (float*)(L + L_WT); float* GC = (float*)(L + L_GC); const float* PAR = (const float*)(L + L_PAR);
        const int c = bc % NCH, b = bc / NCH, item = (b * 16 + h) * NCH + c;
        int pos, row, prow; bool valid; c1_rows(b, c, i, pos, valid, row, prow);
        float rr[8], vr[8], lw[8], av[8], bv[8], kp[8];
        {
            float mur[8], muk[8], muv[8], w0v[8], a0v[8], kkv[8], kav[8], rkv[8];
#pragma unroll
            for (int e = 0; e < 8; ++e) { mur[e] = PAR[c0 + e]; muk[e] = PAR[64 + c0 + e]; muv[e] = PAR[128 + c0 + e]; w0v[e] = PAR[192 + c0 + e]; a0v[e] = PAR[256 + c0 + e];
                kkv[e] = PAR[320 + c0 + e]; kav[e] = PAR[384 + c0 + e]; rkv[e] = PAR[448 + c0 + e]; }
            float kr[8], z[8], zp[8];
            unpack8(cur.z[0], z); unpack8(cur.zp[0], zp);
#pragma unroll
            for (int e = 0; e < 8; ++e) { const float zq = prow >= 0 ? zp[e] : 0.f; rr[e] = z[e] + (zq - z[e]) * mur[e]; }
            unpack8(cur.z[1], z); unpack8(cur.zp[1], zp);
#pragma unroll
            for (int e = 0; e < 8; ++e) { const float zq = prow >= 0 ? zp[e] : 0.f; kr[e] = z[e] + (zq - z[e]) * muk[e]; }
            unpack8(cur.z[2], z); unpack8(cur.zp[2], zp);
#pragma unroll
            for (int e = 0; e < 8; ++e) { const float zq = prow >= 0 ? zp[e] : 0.f; vr[e] = z[e] + (zq - z[e]) * muv[e]; }
            float dec[8], aa[8]; unpack8(cur.dec, dec); unpack8(cur.aa, aa);
            { const int bn = bc + bcs; if (bn < NBC) c1_load(cur, ZR, LODA, bn / NCH, bn % NCH, i, col); }
            float ss = 0.f, bon = 0.f, as[8], kk[8];
#pragma unroll
            for (int e = 0; e < 8; ++e) {
                lw[e] = -DECAY_SCALE * sigmoidf_(w0v[e] + dec[e]);
                as[e] = sigmoidf_(a0v[e] + aa[e]);
                kk[e] = kr[e] * kkv[e]; ss += kk[e] * kk[e];
                kp[e] = kr[e] * (1.0f + (as[e] - 1.0f) * kav[e]);
                bon += rr[e] * kp[e] * rkv[e];
            }
            ss += __shfl_xor(ss, 1); ss += __shfl_xor(ss, 2); ss += __shfl_xor(ss, 4);
            bon += __shfl_xor(bon, 1); bon += __shfl_xor(bon, 2); bon += __shfl_xor(bon, 4);
            const float inv = __builtin_amdgcn_rcpf(fmaxf(__builtin_amdgcn_sqrtf(ss), 1e-12f));
#pragma unroll
            for (int e = 0; e < 8; ++e) { const float kn = kk[e] * inv; av[e] = -kn; bv[e] = kn * as[e]; }
            if (!valid) {
#pragma unroll
                for (int e = 0; e < 8; ++e) { lw[e] = 0.f; rr[e] = 0.f; kp[e] = 0.f; vr[e] = 0.f; av[e] = 0.f; bv[e] = 0.f; } }
            if (cgp == 0 && valid) BON[((size_t)b * (NCH * 64) + pos) * NHEAD + h] = bon;
        }
        float Lc[8];
#pragma unroll
        for (int e = 0; e < 8; ++e) { float v = lw[e];
            float t = __shfl_up(v, 8); if (lane >= 8) v += t;
            t = __shfl_up(v, 16); if (lane >= 16) v += t;
            t = __shfl_up(v, 32); if (lane >= 32) v += t;
            Lc[e] = v; }
        if (lane >= 56) { *(f32x4*)(WT + wave * 64 + c0) = (f32x4){Lc[0], Lc[1], Lc[2], Lc[3]}; *(f32x4*)(WT + wave * 64 + c0 + 4) = (f32x4){Lc[4], Lc[5], Lc[6], Lc[7]}; }
        __syncthreads();
        {
            float pre[8], tot[8];
#pragma unroll
            for (int e = 0; e < 8; ++e) { pre[e] = 0.f; tot[e] = 0.f; }
#pragma unroll
            for (int g = 0; g < 8; ++g) { const f32x4 t0 = *(const f32x4*)(WT + g * 64 + c0), t1 = *(const f32x4*)(WT + g * 64 + c0 + 4);
                const float tv[8] = {t0.x, t0.y, t0.z, t0.w, t1.x, t1.y, t1.z, t1.w};
#pragma unroll
                for (int e = 0; e < 8; ++e) { tot[e] += tv[e]; if (g < wave) pre[e] += tv[e]; } }
            float at[8], rt[8], bt[8], kt[8];
            const int swb = ((wave ^ cgp) * 16) + (i & 7) * 2;
#pragma unroll
            for (int e = 0; e < 8; ++e) {
                const float Lv = Lc[e] + pre[e], Lt = tot[e];
                const float eL = __expf(Lv), eLex = __expf(Lv - lw[e]), einv = __expf(-Lv), eh = __expf(Lt - Lv);
                at[e] = av[e] * eLex; rt[e] = rr[e] * eL; bt[e] = bv[e] * einv; kt[e] = kp[e] * einv;
                *(bf16*)(L + L_BHT + (c0 + e) * LP + swb) = (bf16)f2bf(bv[e] * eh);
                *(bf16*)(L + L_KHT + (c0 + e) * LP + swb) = (bf16)f2bf(kp[e] * eh);
                *(bf16*)(L + L_VT + (c0 + e) * LP + swb) = (bf16)f2bf(vr[e]);
                if (i == 63) GC[c0 + e] = eL;
            }
            *(v4u*)(L + L_AT + i * LP + c0 * 2) = pack8(at); *(v4u*)(L + L_RT + i * LP + c0 * 2) = pack8(rt);
            *(v4u*)(L + L_BT + i * LP + c0 * 2) = pack8(bt); *(v4u*)(L + L_KT + i * LP + c0 * 2) = pack8(kt);
        }
        __syncthreads();
        {
            f32x4 aab[2], aak[2], arb[2], ark[2];
#pragma unroll
            for (int t = 0; t < 2; ++t) { aab[t] = (f32x4){0.f, 0.f, 0.f, 0.f}; aak[t] = aab[t]; arb[t] = aab[t]; ark[t] = aab[t]; }
#pragma unroll
            for (int s = 0; s < 2; ++s) {
                const bf16x8 fa = ldfrag(L + L_AT, tm * 16 + r16, s, q), fr_ = ldfrag(L + L_RT, tm * 16 + r16, s, q);
#pragma unroll
                for (int t = 0; t < 2; ++t) {
                    const bf16x8 fb = ldfrag(L + L_BT, (tn0 + t) * 16 + r16, s, q), fk = ldfrag(L + L_KT, (tn0 + t) * 16 + r16, s, q);
                    aab[t] = MFMA16(fa, fb, aab[t]); aak[t] = MFMA16(fa, fk, aak[t]); arb[t] = MFMA16(fr_, fb, arb[t]); ark[t] = MFMA16(fr_, fk, ark[t]);
                }
            }
#pragma unroll
            for (int t = 0; t < 2; ++t)
#pragma unroll
                for (int jj = 0; jj < 4; ++jj) {
                    const int ri = tm * 16 + 4 * q + jj, cj = (tn0 + t) * 16 + r16;
                    st_bf(L + L_AAB, ri, cj, cj < ri ? aab[t][jj] : 0.f);
                    st_bf(L + L_AAK, ri, cj, cj < ri ? aak[t][jj] : 0.f);
                    st_bf(L + L_ARB, ri, cj, cj <= ri ? arb[t][jj] : 0.f);
                    st_bf(L + L_ARK, ri, cj, cj <= ri ? ark[t][jj] : 0.f);
                }
        }
        __syncthreads();
        if (wave == 0) {
            const int db = lane >> 4, dj = lane & 15; float x[16];
#pragma unroll
            for (int hf = 0; hf < 2; ++hf) {
                v4u ra[8][2];
#pragma unroll
                for (int r8 = 0; r8 < 8; ++r8) { const int r = hf * 8 + r8;
                    ra[r8][0] = *(const v4u*)(L + L_AAB + (16 * db + r) * LP + (16 * db) * 2); ra[r8][1] = *(const v4u*)(L + L_AAB + (16 * db + r) * LP + (16 * db + 8) * 2); }
#pragma unroll
                for (int r8 = 0; r8 < 8; ++r8) { const int r = hf * 8 + r8;
                    float a[16]; float t0[8], t1[8]; unpack8(ra[r8][0], t0); unpack8(ra[r8][1], t1);
#pragma unroll
                    for (int e = 0; e < 8; ++e) { a[e] = t0[e]; a[8 + e] = t1[e]; }
                    float acc = (r == dj) ? 1.0f : 0.f;
#pragma unroll
                    for (int k = 0; k < 16; ++k) if (k < r) acc = fmaf(a[k], x[k], acc);
                    x[r] = acc; }
                asm volatile("" ::: "memory");
            }
#pragma unroll
            for (int r = 0; r < 16; ++r) *(bf16*)(L + L_TD + db * 512 + r * 32 + dj * 2) = (bf16)f2bf(x[r]);
        }
        f32x4 y1a[2], nna[2], Rs[4];
        {
#pragma unroll
            for (int t = 0; t < 2; ++t) { y1a[t] = (f32x4){0.f, 0.f, 0.f, 0.f}; nna[t] = y1a[t]; }
#pragma unroll
            for (int s = 0; s < 2; ++s) {
                const bf16x8 frk = ldfrag(L + L_ARK, tm * 16 + r16, s, q), fkh = ldfrag_sw(L + L_KHT, tm * 16 + r16, s, q);
#pragma unroll
                for (int t = 0; t < 2; ++t) {
                    const bf16x8 fv = ldfrag_sw(L + L_VT, (tn0 + t) * 16 + r16, s, q);
                    y1a[t] = MFMA16(frk, fv, y1a[t]); nna[t] = MFMA16(fkh, fv, nna[t]);
                }
            }
            if (wave < 4) {
#pragma unroll
                for (int bb = 0; bb < 4; ++bb)
#pragma unroll
                    for (int jj = 0; jj < 4; ++jj) Rs[bb][jj] = bf2f(*(const bf16*)(L + L_AT + (16 * bb + 4 * q + jj) * LP + (16 * wave + r16) * 2));
            } else {
#pragma unroll
                for (int bb = 0; bb < 4; ++bb) Rs[bb] = (f32x4){0.f, 0.f, 0.f, 0.f};
#pragma unroll
                for (int s = 0; s < 2; ++s) {
                    const bf16x8 fv = ldfrag_sw(L + L_VT, (wave - 4) * 16 + r16, s, q);
#pragma unroll
                    for (int bb = 0; bb < 4; ++bb) Rs[bb] = MFMA16(ldfrag(L + L_AAK, 16 * bb + r16, s, q), fv, Rs[bb]);
                }
            }
        }
        __syncthreads();
        {
            bf16x8 xb[4];
#pragma unroll
            for (int bb = 0; bb < 4; ++bb) {
                f32x4 acc = Rs[bb];
#pragma unroll
                for (int bp = 0; bp < 4; ++bp) if (bp < bb) acc = MFMA16(half_frag(*(const v2u*)(L + L_AAB + (16 * bb + r16) * LP + (16 * bp + 4 * q) * 2)), xb[bp], acc);
                v2u pb; pb.x = pk2(acc[0], acc[1]); pb.y = pk2(acc[2], acc[3]);
                const f32x4 xa = MFMA16(half_frag(*(const v2u*)(L + L_TD + bb * 512 + r16 * 32 + 4 * q * 2)), half_frag(pb), ((f32x4){0.f, 0.f, 0.f, 0.f}));
                v2u px; px.x = pk2(xa[0], xa[1]); px.y = pk2(xa[2], xa[3]);
                xb[bb] = half_frag(px);
                *(v2u*)(L + L_XT + (16 * wave + r16) * LP + (16 * bb + 4 * q) * 2) = px;
            }
        }
        __syncthreads();
        f32x4 qa[2], ma[2];
        {
#pragma unroll
            for (int t = 0; t < 2; ++t) { qa[t] = (f32x4){0.f, 0.f, 0.f, 0.f}; ma[t] = qa[t]; }
#pragma unroll
            for (int s = 0; s < 2; ++s) {
                const bf16x8 frb = ldfrag(L + L_ARB, tm * 16 + r16, s, q), fbh = ldfrag_sw(L + L_BHT, tm * 16 + r16, s, q);
#pragma unroll
                for (int t = 0; t < 2; ++t) {
                    const bf16x8 fw = ldfrag(L + L_XT, (tn0 + t) * 16 + r16, s, q), fu = ldfrag(L + L_XT, 64 + (tn0 + t) * 16 + r16, s, q);
                    qa[t] = MFMA16(frb, fw, qa[t]); y1a[t] = MFMA16(frb, fu, y1a[t]); ma[t] = MFMA16(fbh, fw, ma[t]); nna[t] = MFMA16(fbh, fu, nna[t]);
                }
            }
#pragma unroll
            for (int t = 0; t < 2; ++t)
#pragma unroll
                for (int jj = 0; jj < 4; ++jj) {
                    const int ri = tm * 16 + 4 * q + jj, cj = (tn0 + t) * 16 + r16;
                    qa[t][jj] += bf2f(*(const bf16*)(L + L_RT + ri * LP + cj * 2));
                    if (ri == cj) ma[t][jj] += GC[ri];
                }
        }
        __syncthreads();
#pragma unroll
        for (int t = 0; t < 2; ++t)
#pragma unroll
            for (int jj = 0; jj < 4; ++jj) {
                const int ri = tm * 16 + 4 * q + jj, cj = (tn0 + t) * 16 + r16;
                st_bf(L + L_SQ, ri, cj, qa[t][jj]); st_bf(L + L_SM, ri, cj, ma[t][jj]); st_bf(L + L_SN, ri, cj, nna[t][jj]); st_bf(L + L_SY, ri, cj, y1a[t][jj]);
            }
        __syncthreads();
        {
            const int fi = tid >> 6, mt = fi >> 1, s = fi & 1; const int srow = 16 * mt + r16;
            const v2u q0 = *(const v2u*)(L + L_SQ + srow * LP + (32 * s + 4 * q) * 2), q1 = *(const v2u*)(L + L_SQ + srow * LP + (32 * s + 16 + 4 * q) * 2);
            const v2u m0 = *(const v2u*)(L + L_SM + srow * LP + (32 * s + 4 * q) * 2), m1 = *(const v2u*)(L + L_SM + srow * LP + (32 * s + 16 + 4 * q) * 2);
            *(v4u*)(ws + WS_QF + (size_t)item * 8192 + tid * 16) = (v4u){q0.x, q0.y, q1.x, q1.y};
            *(v4u*)(ws + WS_MF + (size_t)item * 8192 + tid * 16) = (v4u){m0.x, m0.y, m1.x, m1.y};
            const int g4 = (tid >> 6) & 3; float o[16];
            if (tid < 256) {
#pragma unroll
                for (int m2 = 0; m2 < 4; ++m2)
#pragma unroll
                    for (int jj = 0; jj < 4; ++jj) o[m2 * 4 + jj] = bf2f(*(const bf16*)(L + L_SN + (16 * m2 + 4 * q + jj) * LP + (16 * g4 + r16) * 2));
            } else {
#pragma unroll
                for (int v2 = 0; v2 < 4; ++v2)
#pragma unroll
                    for (int jj = 0; jj < 4; ++jj) o[v2 * 4 + jj] = bf2f(*(const bf16*)(L + L_SY + (16 * g4 + 4 * q + jj) * LP + (16 * v2 + r16) * 2));
            }
            v4u w0, w1; w0.x = pk2(o[0], o[1]); w0.y = pk2(o[2], o[3]); w0.z = pk2(o[4], o[5]); w0.w = pk2(o[6], o[7]); w1.x = pk2(o[8], o[9]); w1.y = pk2(o[10], o[11]); w1.z = pk2(o[12], o[13]); w1.w = pk2(o[14], o[15]);
            unsigned char* dst = ws + (tid < 256 ? WS_NB : WS_Y1) + (size_t)item * 8192 + (size_t)(g4 * 64 + lane) * 32;
            *(v4u*)dst = w0; *(v4u*)(dst + 16) = w1;
        }
        __syncthreads();
    }
}
struct C2Stage { v4u mf[4][2]; v4u nb0, nb1; };
DI void c2_load(C2Stage& st, const unsigned char* ws, int b, int h, int vs, int lane, int cc) {
    const int cl = cc < NCH ? cc : NCH - 1; const size_t item = (size_t)(b * 16 + h) * NCH + cl;
#pragma unroll
    for (int m = 0; m < 4; ++m)
#pragma unroll
        for (int s = 0; s < 2; ++s) st.mf[m][s] = *(const v4u*)(ws + WS_MF + item * 8192 + (size_t)((m * 2 + s) * 64 + lane) * 16);
    st.nb0 = *(const v4u*)(ws + WS_NB + item * 8192 + (size_t)(vs * 64 + lane) * 32); st.nb1 = *(const v4u*)(ws + WS_NB + item * 8192 + (size_t)(vs * 64 + lane) * 32 + 16);
}
DI void c2_step(const C2Stage& st, f32x4 (&Hs)[4], unsigned char* ws, int b, int h, int vs, int lane, int cc) {
    if (cc >= NCH) return;
    const size_t item = (size_t)(b * 16 + h) * NCH + cc;
    v4u hw[2];
#pragma unroll
    for (int s = 0; s < 2; ++s) { hw[s].x = pk2(Hs[2 * s][0], Hs[2 * s][1]); hw[s].y = pk2(Hs[2 * s][2], Hs[2 * s][3]); hw[s].z = pk2(Hs[2 * s + 1][0], Hs[2 * s + 1][1]); hw[s].w = pk2(Hs[2 * s + 1][2], Hs[2 * s + 1][3]);
        *(v4u*)(ws + WS_HST + item * 8192 + (size_t)((vs * 2 + s) * 64 + lane) * 16) = hw[s]; }
    float nf[16]; { float t0[8], t1[8]; unpack8(st.nb0, t0); unpack8(st.nb1, t1);
#pragma unroll
        for (int e = 0; e < 8; ++e) { nf[e] = t0[e]; nf[8 + e] = t1[e]; } }
#pragma unroll
    for (int m = 0; m < 4; ++m) {
        f32x4 acc = (f32x4){nf[m * 4], nf[m * 4 + 1], nf[m * 4 + 2], nf[m * 4 + 3]};
#pragma unroll
        for (int s = 0; s < 2; ++s) acc = MFMA16(__builtin_bit_cast(bf16x8, st.mf[m][s]), __builtin_bit_cast(bf16x8, hw[s]), acc);
        Hs[m] = acc;
    }
    asm volatile("" ::: "memory");
}
DI void phase_c2(const Args& A, int bh, int vs, int lane) {
    unsigned char* ws = A.ws;
    const int b = bh >> 4, h = bh & 15;
    f32x4 Hs[4];
#pragma unroll
    for (int m = 0; m < 4; ++m) Hs[m] = (f32x4){0.f, 0.f, 0.f, 0.f};
    C2Stage s0, s1, s2, s3, s4;
    c2_load(s0, ws, b, h, vs, lane, 0); c2_load(s1, ws, b, h, vs, lane, 1); c2_load(s2, ws, b, h, vs, lane, 2); c2_load(s3, ws, b, h, vs, lane, 3);
#pragma unroll
    for (int c = 0; c < NCH; c += 5) {
        c2_load(s4, ws, b, h, vs, lane, c + 4); c2_step(s0, Hs, ws, b, h, vs, lane, c);
        c2_load(s0, ws, b, h, vs, lane, c + 5); c2_step(s1, Hs, ws, b, h, vs, lane, c + 1);
        c2_load(s1, ws, b, h, vs, lane, c + 6); c2_step(s2, Hs, ws, b, h, vs, lane, c + 2);
        c2_load(s2, ws, b, h, vs, lane, c + 7); c2_step(s3, Hs, ws, b, h, vs, lane, c + 3);
        c2_load(s3, ws, b, h, vs, lane, c + 8); c2_step(s4, Hs, ws, b, h, vs, lane, c + 4);
    }
}
DI void phase_c3(const Args& A, int bx, int G, int wave, int lane) {
    unsigned char* ws = A.ws;
    const bf16* ZR = (const bf16*)(ws + WS_ZR); const bf16* LOG = (const bf16*)(ws + WS_LOG); const float* BON = (const float*)(ws + WS_BON); bf16* YA = (bf16*)(ws + WS_BUFA);
    const float* mu = A.in[5]; const float* lnw = A.in[14]; const float* lnb = A.in[15];
    const int half = wave >> 2, mt = wave & 3, n = lane & 15, q = lane >> 4;
    for (int wi = bx * 2 + half; wi < NITEM; wi += 2 * G) {
        const int h = wi & 15, bc = wi >> 4, c = bc % NCH, b = bc / NCH, item = (b * 16 + h) * NCH + c;
        f32x4 acc[4];
        {
            const v4u y0 = *(const v4u*)(ws + WS_Y1 + (size_t)item * 8192 + (size_t)(mt * 64 + lane) * 32), y1 = *(const v4u*)(ws + WS_Y1 + (size_t)item * 8192 + (size_t)(mt * 64 + lane) * 32 + 16);
            float t0[8], t1[8]; unpack8(y0, t0); unpack8(y1, t1);
            acc[0] = (f32x4){t0[0], t0[1], t0[2], t0[3]}; acc[1] = (f32x4){t0[4], t0[5], t0[6], t0[7]}; acc[2] = (f32x4){t1[0], t1[1], t1[2], t1[3]}; acc[3] = (f32x4){t1[4], t1[5], t1[6], t1[7]};
        }
#pragma unroll
        for (int s = 0; s < 2; ++s) {
            const v4u qf = *(const v4u*)(ws + WS_QF + (size_t)item * 8192 + (size_t)((mt * 2 + s) * 64 + lane) * 16);
#pragma unroll
            for (int vs = 0; vs < 4; ++vs) {
                const v4u hf = *(const v4u*)(ws + WS_HST + (size_t)item * 8192 + (size_t)((vs * 2 + s) * 64 + lane) * 16);
                acc[vs] = MFMA16(__builtin_bit_cast(bf16x8, qf), __builtin_bit_cast(bf16x8, hf), acc[vs]);
            }
        }
        float lw_[4], lb_[4], mv_[4];
#pragma unroll
        for (int vs = 0; vs < 4; ++vs) { const int col = h * 64 + vs * 16 + n; lw_[vs] = lnw[col]; lb_[vs] = lnb[col]; mv_[vs] = mu[2048 + col]; }
        unsigned vv_[4][4], vp_[4][4], gg_[4][4]; float bon_[4]; int row_[4]; bool ok_[4], hp_[4];
#pragma unroll
        for (int jj = 0; jj < 4; ++jj) {
            const int i = 16 * mt + 4 * q + jj, pos = c * 64 + i;
            ok_[jj] = pos < LSEQ && (pos >= NMETA || b == 0);
            const int posc = pos < LSEQ ? pos : LSEQ - 1;
            const int row = posc < NMETA ? MX + posc : b * SEQ + posc - NMETA, prow = prev_row(row);
            row_[jj] = row; hp_[jj] = prow >= 0;
            const int prc = prow >= 0 ? prow : row;
            bon_[jj] = BON[((size_t)b * (NCH * 64) + posc) * NHEAD + h];
#pragma unroll
            for (int vs = 0; vs < 4; ++vs) {
                const int col = h * 64 + vs * 16 + n;
                vv_[jj][vs] = (unsigned)ZR[(size_t)row * ZR_LD + 2048 + col];
                vp_[jj][vs] = (unsigned)ZR[(size_t)prc * ZR_LD + 2048 + col];
                gg_[jj][vs] = (unsigned)LOG[(size_t)row * 1024 + col];
            }
        }
#pragma unroll
        for (int jj = 0; jj < 4; ++jj) {
            float s1 = (acc[0][jj] + acc[1][jj]) + (acc[2][jj] + acc[3][jj]);
            s1 += __shfl_xor(s1, 1); s1 += __shfl_xor(s1, 2); s1 += __shfl_xor(s1, 4); s1 += __shfl_xor(s1, 8);
            const float mean = s1 * (1.0f / 64.0f);
            float d[4], s2 = 0.f;
#pragma unroll
            for (int vs = 0; vs < 4; ++vs) { d[vs] = acc[vs][jj] - mean; s2 += d[vs] * d[vs]; }
            s2 += __shfl_xor(s2, 1); s2 += __shfl_xor(s2, 2); s2 += __shfl_xor(s2, 4); s2 += __shfl_xor(s2, 8);
            const float rstd = __builtin_amdgcn_rsqf(s2 * (1.0f / 64.0f) + GN_EPS);
            if (ok_[jj]) {
#pragma unroll
                for (int vs = 0; vs < 4; ++vs) {
                    const int col = h * 64 + vs * 16 + n;
                    const float vv = bflo(vv_[jj][vs]), vp = hp_[jj] ? bflo(vp_[jj][vs]) : 0.f;
                    const float vsh = vv + (vp - vv) * mv_[vs];
                    const float y = (d[vs] * rstd * lw_[vs] + lb_[vs] + bon_[jj] * vsh) * bflo(gg_[jj][vs]);
                    YA[(size_t)row_[jj] * DM + 1024 + col] = (bf16)f2bf(y);
                }
            }
        }
    }
}
DI void phase4(const Args& A, int gw, int NGW, int lane) {
    unsigned char* ws = A.ws;
    const bf16* MIX = (const bf16*)(ws + WS_MIX); const float* MIXM = (const float*)(ws + WS_MIXM); bf16* N2 = (bf16*)(ws + WS_BUFA); bf16* N2M = (bf16*)(ws + WS_N2M);
    const f32x4* g1 = (const f32x4*)A.in[17] + lane; const f32x4* g2 = (const f32x4*)A.in[18] + lane;
    for (int m = gw; m < MX + 2; m += NGW) {
        const f32x4* hr = (const f32x4*)(m < MX ? A.in[0] + (size_t)m * DM : A.in[1] + (size_t)(14 + m - MX) * DM) + lane;
        f32x4 v[8], hh[8], ga[8], gb[8]; float s = 0.f;
#pragma unroll
        for (int j = 0; j < 8; ++j) { hh[j] = hr[64 * j]; ga[j] = g1[64 * j]; gb[j] = g2[64 * j]; }
        if (m < MX) { const v2u* mr = (const v2u*)(MIX + (size_t)m * DM) + lane;
#pragma unroll
            for (int j = 0; j < 8; ++j) { const v2u w = mr[64 * j]; v[j] = (f32x4){bflo(w.x), bfhi(w.x), bflo(w.y), bfhi(w.y)}; } }
        else { const f32x4* mr = (const f32x4*)(MIXM + (size_t)(m - MX) * DM) + lane;
#pragma unroll
            for (int j = 0; j < 8; ++j) v[j] = mr[64 * j]; }
#pragma unroll
        for (int j = 0; j < 8; ++j) s += (v[j].x * v[j].x + v[j].y * v[j].y) + (v[j].z * v[j].z + v[j].w * v[j].w);
        const float rs = 1.0f / sqrtf(wave_sum(s) * (1.0f / DM) + RMS_EPS);
        float s2 = 0.f;
#pragma unroll
        for (int j = 0; j < 8; ++j) { v[j] = hh[j] + v[j] * rs * ga[j]; s2 += (v[j].x * v[j].x + v[j].y * v[j].y) + (v[j].z * v[j].z + v[j].w * v[j].w); }
        const float rs2 = 1.0f / sqrtf(wave_sum(s2) * (1.0f / DM) + RMS_EPS);
        v2u* o8 = (v2u*)(m < MX ? N2 + (size_t)m * DM : N2M + (size_t)(m - MX) * DM) + lane;
#pragma unroll
        for (int j = 0; j < 8; ++j) { const f32x4 g = gb[j]; o8[64 * j] = (v2u){pk2(v[j].x * rs2 * g.x, v[j].y * rs2 * g.y), pk2(v[j].z * rs2 * g.z, v[j].w * rs2 * g.w)}; }
    }
}
DI void phase6(const Args& A, int gtid, int NT) {
    unsigned char* ws = A.ws;
    const float* G4 = (const float*)(ws + WS_G4); const float* U2 = (const float*)(ws + WS_U2); const float* GM = (const float*)(ws + WS_GM); bf16* ACT = (bf16*)(ws + WS_ACT);
    const float* cw = A.in[20];
    constexpr int C4 = DFF / 4;
    for (int idx = gtid; idx < 256 * 2 * C4; idx += NT) {
        const int c4 = idx % C4, lr = (idx / C4) & 1, rb = idx / (2 * C4), col = c4 * 4;
        const f32x4 g0 = *(const f32x4*)(G4 + (size_t)(rb * 4 + lr) * DFF + col);
        const float* pm2; const float* pm1;
        const float* pb62 = (rb % 128 == 0) ? GM + col : G4 + (size_t)((rb - 1) * 4 + 2) * DFF + col;
        const float* pb63 = (rb % 128 == 0) ? GM + DFF + col : G4 + (size_t)((rb - 1) * 4 + 3) * DFF + col;
        if (lr == 0) { pm2 = pb62; pm1 = pb63; } else { pm2 = pb63; pm1 = G4 + (size_t)(rb * 4 + 0) * DFF + col; }
        const f32x4 gm2 = *(const f32x4*)pm2, gm1 = *(const f32x4*)pm1, up = *(const f32x4*)(U2 + (size_t)(rb * 2 + lr) * DFF + col);
        const f32x4 w0 = *(const f32x4*)(cw + col), w1 = *(const f32x4*)(cw + DFF + col), w2 = *(const f32x4*)(cw + 2 * DFF + col);
        float o[4];
#pragma unroll
        for (int x = 0; x < 4; ++x) { const float cv = w0[x] * gm2[x] + w1[x] * gm1[x] + w2[x] * g0[x]; o[x] = cv * __builtin_amdgcn_rcpf(1.0f + __expf(-cv)) * up[x]; }
        *(v2u*)(ACT + (size_t)(rb * 64 + lr) * DFF + col) = (v2u){pk2(o[0], o[1]), pk2(o[2], o[3])};
    }
}
DI void phase8(const Args& A, int gw, int NGW, int lane) {
    const bf16* F = (const bf16*)(A.ws + WS_F); const bf16* MIX = (const bf16*)(A.ws + WS_MIX);
    const f32x4* g1 = (const f32x4*)A.in[17] + lane; const f32x4* g4 = (const f32x4*)A.in[22] + lane;
    for (int m = gw; m < MX; m += NGW) {
        const v2u* fr = (const v2u*)(F + (size_t)m * DM) + lane; const v2u* mr = (const v2u*)(MIX + (size_t)m * DM) + lane;
        const f32x4* xr = (const f32x4*)(A.in[0] + (size_t)m * DM) + lane; f32x4* orow = (f32x4*)(A.out + (size_t)m * DM) + lane;
        f32x4 v[8], mx[8], hx[8], ga[8], gg[8]; float s = 0.f, sm = 0.f;
#pragma unroll
        for (int j = 0; j < 8; ++j) { hx[j] = xr[64 * j]; ga[j] = g1[64 * j]; gg[j] = g4[64 * j]; }
#pragma unroll
        for (int j = 0; j < 8; ++j) { const v2u w = mr[64 * j]; mx[j] = (f32x4){bflo(w.x), bfhi(w.x), bflo(w.y), bfhi(w.y)}; sm += (mx[j].x * mx[j].x + mx[j].y * mx[j].y) + (mx[j].z * mx[j].z + mx[j].w * mx[j].w); }
#pragma unroll
        for (int j = 0; j < 8; ++j) { const v2u w = fr[64 * j]; v[j] = (f32x4){bflo(w.x), bfhi(w.x), bflo(w.y), bfhi(w.y)}; s += (v[j].x * v[j].x + v[j].y * v[j].y) + (v[j].z * v[j].z + v[j].w * v[j].w); }
        const float rsm = 1.0f / sqrtf(wave_sum(sm) * (1.0f / DM) + RMS_EPS);
        const float rs = 1.0f / sqrtf(wave_sum(s) * (1.0f / DM) + RMS_EPS);
#pragma unroll
        for (int j = 0; j < 8; ++j) orow[64 * j] = (hx[j] + mx[j] * rsm * ga[j]) + v[j] * rs * gg[j];
    }
}
__global__ void __launch_bounds__(NTHR, 2) hymba_fwd(Args args) {
    extern __shared__ __attribute__((aligned(16))) unsigned char lds[];
    cg::grid_group grid = cg::this_grid();
    const int tid = threadIdx.x, lane = tid & 63, wave = __builtin_amdgcn_readfirstlane(tid >> 6);
    const int G = gridDim.x, bx = blockIdx.x;
    const int gw = bx * NWAVES + wave, NGW = G * NWAVES;
    PG8_LAS unsigned char* ldsg = (PG8_LAS unsigned char*)lds;
#ifdef PROBE_A
    unsigned long long* stamps = (unsigned long long*)args.ws; int nst = 0;
#define STAMP() do { if (bx == 0 && tid == 0) stamps[nst] = __builtin_amdgcn_s_memrealtime(); ++nst; } while (0)
#else
#define STAMP() do { } while (0)
#endif
    STAMP();
    volatile __attribute__((address_space(3))) unsigned* MISC = (volatile __attribute__((address_space(3))) unsigned*)(ldsg + LDS_BYTES - 64);
    if (tid < 16) MISC[tid] = 0u;
    __syncthreads();
    XcdBarrier bar = xcd_barrier_post((unsigned*)(args.ws + WS_BAR), MISC + 8);
    if (args.ws == nullptr) grid.sync();

    phase0(args, lds, gw, NGW, wave, lane);
    xcd_barrier(bar); STAMP();
    {
        pg8::Gemm g{(const bf16*)(args.ws + WS_BUFA), (const bf16*)(args.ws + WS_WIN), MP, IN_PAD, DM, DM, DM}; pg8::StaticOrder S; S.init(MP, IN_PAD, G, bx);
        pg8::EpiSplit2 E{(bf16*)(args.ws + WS_ZC), ZC_LD, (bf16*)(args.ws + WS_ZR), ZR_LD, ZC_LD};
        pg8::gemm_phase<pg8::EpiSplit2, pg8::StaticOrder, true, true>(ldsg, g, S, E);
    }
    xcd_barrier(bar); STAMP();
    phase2a(args, gw, NGW, lane);
    xcd_barrier(bar); STAMP();
    {
        if (wave == 0 && bx < 192) {
            const int n0 = bx * 16, seg = n0 >> 10, r16 = lane & 15, q = lane >> 4;
            const bf16* LAx = (const bf16*)(args.ws + (seg == 2 ? WS_LA2 : WS_LA1)); const bf16* WLx = seg == 2 ? (const bf16*)(args.ws + WS_WL2) + (size_t)(n0 - 2048) * 256 : (const bf16*)(args.ws + WS_WL1) + (size_t)n0 * 256;
            const int ks0 = seg == 1 ? 4 : 0, nks = seg == 2 ? 8 : 3;
            v4u af[8], bfr[8];
#pragma unroll
            for (int s = 0; s < 8; ++s) { const int sc = s < nks ? s : 0;
                af[s] = *(const v4u*)(LAx + (size_t)(MX + r16) * 256 + (ks0 + sc) * 32 + q * 8); bfr[s] = *(const v4u*)(WLx + (size_t)r16 * 256 + (ks0 + sc) * 32 + q * 8); }
            f32x4 acc = (f32x4){0.f, 0.f, 0.f, 0.f};
#pragma unroll
            for (int s = 0; s < 8; ++s) if (s < nks) acc = MFMA16(__builtin_bit_cast(bf16x8, af[s]), __builtin_bit_cast(bf16x8, bfr[s]), acc);
            bf16* dst = n0 < 2048 ? (bf16*)(args.ws + WS_LODA) : (bf16*)(args.ws + WS_LOG); const int ldd = n0 < 2048 ? 2048 : 1024, nc = (n0 < 2048 ? n0 : n0 - 2048) + r16;
#pragma unroll
            for (int jj = 0; jj < 4; ++jj) dst[(size_t)(MX + 4 * q + jj) * ldd + nc] = (bf16)f2bf(acc[jj]);
        }
        {
            pg8::Gemm g{(const bf16*)(args.ws + WS_LA1), (const bf16*)(args.ws + WS_WL1), MX, 2048, 256, 256, 256}; pg8::StaticOrder S; S.init(MX, 2048, G, bx);
            pg8::EpiSplit2 E{(bf16*)(args.ws + WS_LODA), 2048, nullptr, 0, 1 << 30};
            pg8::gemm_phase<pg8::EpiSplit2, pg8::StaticOrder, true, true>(ldsg, g, S, E);
        }
        {
            pg8::Gemm g{(const bf16*)(args.ws + WS_LA2), (const bf16*)(args.ws + WS_WL2), MX, 1024, 256, 256, 256}; pg8::StaticOrder S; S.init(MX, 1024, G, bx);
            pg8::EpiSplit2 E{(bf16*)(args.ws + WS_LOG), 1024, nullptr, 0, 1 << 30};
            pg8::gemm_phase<pg8::EpiSplit2, pg8::StaticOrder, true, true>(ldsg, g, S, E);
        }
    }
    xcd_barrier(bar); STAMP();
    phase_c1(args, lds, bx, G, tid, wave, lane);
    xcd_barrier(bar); STAMP();
    if (bx < 32) { if (wave < 4) phase_c2(args, bx, wave, lane);
#ifdef PROBE_A
        if (bx == 0 && tid == 0) stamps[20] = __builtin_amdgcn_s_memrealtime();
#endif
    }
    else {
        {
            constexpr int N_LATE = (DM / 64) * (2 * DFF / 64) + (DFF / 64) * (DM / 64);
            const int Gc = G - 32, cb = bx - 32, n3 = 512 - 2 * Gc;
            if (n3 > 0 && n3 < Gc) {
                const int share3 = 16 * n3;
                if (cb < n3) convert_late(args, lds, cb * NWAVES + wave, n3 * NWAVES, wave, lane, 0, share3);
                else convert_late(args, lds, (cb - n3) * NWAVES + wave, (Gc - n3) * NWAVES, wave, lane, share3, N_LATE);
            } else convert_late(args, lds, cb * NWAVES + wave, Gc * NWAVES, wave, lane, 0, N_LATE);
        }
        __syncthreads();
        pg8::Gemm g{(const bf16*)(args.ws + WS_BUFA), (const bf16*)(args.ws + WS_WOUT), MX, DM, 1024, DM, DM}; pg8::StaticOrder S; S.init(MX, DM, G - 32, bx - 32);
        pg8::EpiSplit2 E{(bf16*)args.out, DM, nullptr, 0, 1 << 30};
        pg8::gemm_phase<pg8::EpiSplit2, pg8::StaticOrder, true, true>(ldsg, g, S, E);
    }
    xcd_barrier(bar); STAMP();
    phase_c3(args, bx, G, wave, lane);
    xcd_barrier(bar); STAMP();
    {
        const bf16* YA = (const bf16*)(args.ws + WS_BUFA); const bf16* WOUT = (const bf16*)(args.ws + WS_WOUT); float* MIXM = (float*)(args.ws + WS_MIXM);
        for (int n = gw; n < DM; n += NGW) { const bf16* const br[1] = {WOUT + (size_t)n * DM}; float o0[1], o1[1];
            gemv2_rows<1>(YA + (size_t)(MX + 14) * DM, YA + (size_t)(MX + 15) * DM, br, lane, o0, o1); if (lane == 0) { MIXM[n] = o0[0]; MIXM[DM + n] = o1[0]; } }
        pg8::Gemm g{YA + 1024, WOUT + 1024, MX, DM, 1024, DM, DM}; pg8::StaticOrder S; S.init(MX, DM, G, bx);
        pg8::EpiAddBf16 E{(const bf16*)args.out, (bf16*)(args.ws + WS_MIX), DM};
        pg8::gemm_phase<pg8::EpiAddBf16, pg8::StaticOrder, true, true>(ldsg, g, S, E);
    }
    xcd_barrier(bar); STAMP();
    phase4(args, gw, NGW, lane);
    xcd_barrier(bar); STAMP();
    {
        const bf16* N2 = (const bf16*)(args.ws + WS_BUFA); const bf16* N2M = (const bf16*)(args.ws + WS_N2M); const bf16* WGU = (const bf16*)(args.ws + WS_WGU); float* GM = (float*)(args.ws + WS_GM);
        if (gw < DFF) {
            int jc[3]; const bf16* br[3]; float o0[3], o1[3];
#pragma unroll
            for (int c = 0; c < 3; ++c) { const int j = gw + c * NGW; jc[c] = j < DFF ? j : gw; br[c] = WGU + (size_t)(256 * (jc[c] >> 7) + (jc[c] & 127)) * DM; }
            gemv2_rows<3>(N2M, N2M + DM, br, lane, o0, o1);
            if (lane == 0) {
#pragma unroll
                for (int c = 0; c < 3; ++c) if (gw + c * NGW < DFF) { GM[jc[c]] = o0[c]; GM[DFF + jc[c]] = o1[c]; } }
        }
        pg8::Gemm g{N2, WGU, MX, 2 * DFF, DM, DM, DM}; pg8::StaticOrder S; S.init(MX, 2 * DFF, G, bx);
        pg8::EpiAct E{(bf16*)(args.ws + WS_ACT), (float*)(args.ws + WS_G4), (float*)(args.ws + WS_U2), args.in[20], DFF};
        pg8::gemm_phase<pg8::EpiAct, pg8::StaticOrder, true, true>(ldsg, g, S, E);
    }
    xcd_barrier(bar); STAMP();
    phase6(args, bx * NTHR + tid, G * NTHR);
    xcd_barrier(bar); STAMP();
    {
        pg8::Gemm g{(const bf16*)(args.ws + WS_ACT), (const bf16*)(args.ws + WS_WDN), MX, DM, DFF, DFF, DFF}; pg8::StaticOrder S; S.init(MX, DM, G, bx);
        pg8::EpiSplit2 E{(bf16*)(args.ws + WS_F), DM, nullptr, 0, 1 << 30};
        pg8::gemm_phase<pg8::EpiSplit2, pg8::StaticOrder, true, true>(ldsg, g, S, E);
    }
    xcd_barrier(bar); STAMP();
    phase8(args, gw, NGW, lane);
#ifdef PROBE_A
    xcd_barrier(bar); STAMP();
    if (bx == 0) {
        const float ta = PROBE_A == 100 ? (float)(stamps[20] - stamps[5]) * 0.01f : (float)(stamps[PROBE_A + 1] - stamps[PROBE_A]) * 0.01f;
        if (tid == 0) args.out[0] = ta * PROBE_SCALE;
    }
#endif
}

extern "C" void kernel_launch(void* const* d_in, const int* in_sizes, int n_in, void* d_out, int out_size, void* d_ws, size_t ws_size, hipStream_t stream) {
    static int grid = 0;
    if (grid == 0) {
        if (n_in != 23 || out_size != MX * DM || ws_size < WS_END) { fprintf(stderr, "kernel_launch: unexpected shapes (n_in %d, out %d, ws %zu)\n", n_in, out_size, ws_size); grid = -1; return; }
        int dev = 0, cus = 0, per_cu = 0;
        if (hipGetDevice(&dev) != hipSuccess || hipDeviceGetAttribute(&cus, hipDeviceAttributeMultiprocessorCount, dev) != hipSuccess) { grid = -1; return; }
        if (hipFuncSetAttribute((const void*)hymba_fwd, hipFuncAttributeMaxDynamicSharedMemorySize, LDS_BYTES) != hipSuccess) { fprintf(stderr, "kernel_launch: hipFuncSetAttribute failed\n"); grid = -1; return; }
        if (hipOccupancyMaxActiveBlocksPerMultiprocessor(&per_cu, (const void*)hymba_fwd, NTHR, LDS_BYTES) != hipSuccess || per_cu < 1) { fprintf(stderr, "kernel_launch: occupancy query says %d\n", per_cu); per_cu = 1; }
        (void)hipGetLastError();
        grid = (cus / 16) * 16;
        if (grid < 240) { fprintf(stderr, "kernel_launch: needs >= 240 CUs\n"); grid = -1; return; }
    }
    if (grid < 0) return;
    if (hipMemsetAsync((char*)d_ws, 0, 131072, stream) != hipSuccess) { fprintf(stderr, "kernel_launch: memset failed\n"); return; }
    Args a{};
    for (int i = 0; i < 23; ++i) a.in[i] = (const float*)d_in[i];
    a.out = (float*)d_out; a.ws = (unsigned char*)d_ws;
    void* kargs[] = {&a};
    hipError_t e = hipLaunchCooperativeKernel((const void*)hymba_fwd, dim3(grid), dim3(NTHR), kargs, LDS_BYTES, stream);
    if (e != hipSuccess) fprintf(stderr, "kernel_launch: cooperative launch failed: %s (grid %d)\n", hipGetErrorString(e), grid);
}
```
